# Optimizing an MI355X kernel written in HIP

```python
import math
import jax, jax.numpy as jnp
from jax import lax
import numpy as np

D_MODEL = 1024
BATCH = 1
SEQ = 16384
DEPTH = 1

CHUNK = 64
EPS = 1e-6
GLA_HEADS = 4
GLA_DK = 128
GLA_DV = 256
GLA_LOWRANK = 16
GLA_TAU = 16.0
DIFF_HEADS = 8
DIFF_DH = 64
DIFF_DV = 2 * DIFF_DH
ROPE_THETA = 500000.0
ROT_DIM = DIFF_DH // 4
Q_BLOCK = 128
N_EXPERTS = 256
TOP_K = 8
N_GROUPS = 8
TOPK_GROUPS = 4
D_EXPERT = 256
D_SHARED = 256
ROUTED_SCALE = 2.5
MOE_BLOCK = 128

GLA_QK = GLA_HEADS * GLA_DK
GLA_V = GLA_HEADS * GLA_DV
DIFF_QK = DIFF_HEADS * 2 * DIFF_DH
DIFF_V = DIFF_HEADS * DIFF_DV
SPLITS = (GLA_QK, GLA_QK, GLA_V, GLA_LOWRANK, GLA_V, DIFF_QK, DIFF_QK, DIFF_V, D_MODEL, D_MODEL)
IN_WIDTH = GLA_QK * 2 + GLA_V * 2 + GLA_LOWRANK + DIFF_QK * 2 + DIFF_V + 2 * D_MODEL

kernel_name = "hybrid_gla_diffattn_moe_adaln_block"


def rms_norm(x, g):
    xf = x.astype(jnp.float32)
    y = xf * lax.rsqrt(jnp.mean(xf * xf, axis=-1, keepdims=True) + EPS)
    return (y * g.astype(jnp.float32)).astype(x.dtype)


def rope_tables(positions):
    pos = positions.astype(jnp.float32)
    inv_freq = ROPE_THETA ** (-jnp.arange(0, ROT_DIM, 2, dtype=jnp.float32) / ROT_DIM)
    ang = pos[..., None] * inv_freq
    return jnp.cos(ang)[:, None, None], jnp.sin(ang)[:, None, None]


def apply_partial_rope(t, cos, sin):
    tf = t.astype(jnp.float32)
    half = ROT_DIM // 2
    t1, t2, rest = tf[..., :half], tf[..., half:ROT_DIM], tf[..., ROT_DIM:]
    out = jnp.concatenate([t1 * cos - t2 * sin, t2 * cos + t1 * sin, rest], axis=-1)
    return out.astype(t.dtype)


def gla_mixer(q, k, v, a_low, g, w_a2, b_a, onorm_g):
    B, S, _ = q.shape
    N = S // CHUNK
    log_a = jax.nn.log_sigmoid((a_low @ w_a2 + b_a).astype(jnp.float32)) / GLA_TAU

    def to_chunks(t, d):
        return t.astype(jnp.float32).reshape(B, N, CHUNK, GLA_HEADS, d).transpose(1, 0, 3, 2, 4)

    qh = to_chunks(q, GLA_DK) * (GLA_DK ** -0.5)
    kh = to_chunks(k, GLA_DK)
    vh = to_chunks(v, GLA_DV)
    lah = to_chunks(log_a, GLA_DK)
    cum = jnp.cumsum(lah, axis=3)
    tot = cum[:, :, :, -1]
    kd = kh * jnp.exp(tot[:, :, :, None, :] - cum)

    def step(state, inp):
        qc, kc, vc, tc = inp
        state = jnp.exp(tc)[..., None] * state + jnp.einsum('bhcd,bhce->bhde', kc, vc)
        o = jnp.einsum('bhcd,bhde->bhce', qc, state)
        return state, o

    state0 = jnp.zeros((B, GLA_HEADS, GLA_DK, GLA_DV), jnp.float32)
    _, o = lax.scan(step, state0, (qh, kd, vh, tot))
    o = o.transpose(1, 0, 3, 2, 4).reshape(B, S, GLA_HEADS, GLA_DV)
    o = rms_norm(o, onorm_g) * jax.nn.silu(g.astype(jnp.float32).reshape(B, S, GLA_HEADS, GLA_DV))
    return o.reshape(B, S, GLA_V).astype(q.dtype)


def diff_mixer(q, k, v, cos, sin, qn_g, kn_g, lq1, lk1, lq2, lk2, subln_g, lambda_init):
    B, S, _ = q.shape
    qh = q.reshape(B, S, DIFF_HEADS, 2, DIFF_DH).transpose(0, 2, 3, 1, 4)
    kh = k.reshape(B, S, DIFF_HEADS, 2, DIFF_DH).transpose(0, 2, 3, 1, 4)
    vh = v.reshape(B, S, DIFF_HEADS, DIFF_DV).transpose(0, 2, 1, 3)
    qh = apply_partial_rope(rms_norm(qh, qn_g), cos, sin)
    kh = apply_partial_rope(rms_norm(kh, kn_g), cos, sin)
    f32 = jnp.float32
    lam = (jnp.exp(jnp.sum(lq1.astype(f32) * lk1.astype(f32)))
           - jnp.exp(jnp.sum(lq2.astype(f32) * lk2.astype(f32))) + lambda_init)

    nb = S // Q_BLOCK
    q_blocks = qh.reshape(B, DIFF_HEADS, 2, nb, Q_BLOCK, DIFF_DH).transpose(3, 0, 1, 2, 4, 5)
    key_chunk = jnp.arange(S) // CHUNK
    q_chunk = (jnp.arange(S) // CHUNK).reshape(nb, Q_BLOCK)
    scale = DIFF_DH ** -0.5

    def attend(args):
        qb, qc = args
        s = jnp.einsum('bhmqd,bhmkd->bhmqk', qb, kh).astype(f32) * scale
        mask = key_chunk[None, :] <= qc[:, None]
        s = jnp.where(mask, s, -jnp.inf)
        p = jax.nn.softmax(s, axis=-1)
        attn = p[:, :, 0] - lam * p[:, :, 1]
        return jnp.einsum('bhqk,bhke->bhqe', attn.astype(vh.dtype), vh)

    o = lax.map(attend, (q_blocks, q_chunk))
    o = o.transpose(1, 0, 3, 2, 4).reshape(B, S, DIFF_HEADS, DIFF_DV)
    o = rms_norm(o, subln_g) * (1.0 - lambda_init)
    return o.reshape(B, S, DIFF_V).astype(q.dtype)


def swiglu(h, wg, wu, wd):
    return (jax.nn.silu(h @ wg) * (h @ wu)) @ wd


def routed_moe(hf, w_router, router_bias, wg, wu, wd):
    T, D = hf.shape
    E = N_EXPERTS
    scores = jax.nn.sigmoid((hf @ w_router).astype(jnp.float32))
    biased = scores + router_bias.astype(jnp.float32)
    grp = biased.reshape(T, N_GROUPS, E // N_GROUPS)
    grp_score = jnp.sum(lax.top_k(grp, 2)[0], axis=-1)
    _, top_grp = lax.top_k(grp_score, TOPK_GROUPS)
    grp_mask = jnp.sum(jax.nn.one_hot(top_grp, N_GROUPS, dtype=jnp.float32), axis=-2) > 0
    expert_mask = jnp.repeat(grp_mask, E // N_GROUPS, axis=-1)
    masked = jnp.where(expert_mask, biased, -jnp.inf)
    _, idx = lax.top_k(masked, TOP_K)
    sel = jnp.take_along_axis(scores, idx, axis=-1)
    wts = sel / jnp.sum(sel, axis=-1, keepdims=True) * ROUTED_SCALE

    M = T * TOP_K
    flat_e = idx.reshape(M).astype(jnp.int32)
    flat_t = jnp.repeat(jnp.arange(T, dtype=jnp.int32), TOP_K)
    flat_w = wts.reshape(M)
    order = jnp.argsort(flat_e)
    se = flat_e[order]
    counts = jnp.bincount(flat_e, length=E).astype(jnp.int32)
    pcounts = ((counts + MOE_BLOCK - 1) // MOE_BLOCK) * MOE_BLOCK
    pend = jnp.cumsum(pcounts)
    pstart = pend - pcounts
    start = jnp.cumsum(counts) - counts
    dest = pstart[se] + jnp.arange(M, dtype=jnp.int32) - start[se]
    n_blocks = -(-M // MOE_BLOCK) + E
    m_pad = n_blocks * MOE_BLOCK
    tok_pad = jnp.zeros((m_pad,), jnp.int32).at[dest].set(flat_t[order])
    w_pad = jnp.zeros((m_pad,), hf.dtype).at[dest].set(flat_w[order].astype(hf.dtype))
    blk_e = jnp.minimum(jnp.searchsorted(pend, jnp.arange(n_blocks, dtype=jnp.int32) * MOE_BLOCK,
                                         side='right'), E - 1).astype(jnp.int32)

    def body(y, blk):
        tok, e, wt = blk
        out = swiglu(hf[tok], wg[e], wu[e], wd[e])
        return y.at[tok].add(out * wt[:, None]), None

    y, _ = lax.scan(body, jnp.zeros((T, D), hf.dtype),
                    (tok_pad.reshape(n_blocks, MOE_BLOCK), blk_e, w_pad.reshape(n_blocks, MOE_BLOCK)))
    return y


def setup_inputs(seed: int = 0) -> dict:
    key = jax.random.key(seed)
    ks = iter(jax.random.split(key, 40))
    L, D, E, F = DEPTH, D_MODEL, N_EXPERTS, D_EXPERT

    def nrm(shape, scale):
        return jax.random.normal(next(ks), shape, jnp.float32) * scale

    def gain(shape):
        return 1.0 + nrm(shape, 0.02)

    return {
        "x": nrm((BATCH, SEQ, D), 1.0),
        "c": nrm((BATCH, D), 1.0),
        "positions": (jax.random.randint(next(ks), (BATCH, 1), 0, 65536, jnp.int32)
                      + jnp.arange(SEQ, dtype=jnp.int32)[None, :]),
        "w_ada": nrm((L, D, 6 * D), 0.3 * D ** -0.5),
        "b_ada": nrm((L, 6 * D), 0.02),
        "norm1_g": gain((L, D)),
        "w_in": nrm((L, D, IN_WIDTH), D ** -0.5),
        "gla_w_a2": nrm((L, GLA_LOWRANK, GLA_QK), GLA_LOWRANK ** -0.5),
        "gla_b_a": nrm((L, GLA_QK), 0.1),
        "gla_onorm_g": gain((L, GLA_DV)),
        "diff_qnorm_g": gain((L, DIFF_DH)),
        "diff_knorm_g": gain((L, DIFF_DH)),
        "diff_lq1": nrm((L, DIFF_DH), 0.1),
        "diff_lk1": nrm((L, DIFF_DH), 0.1),
        "diff_lq2": nrm((L, DIFF_DH), 0.1),
        "diff_lk2": nrm((L, DIFF_DH), 0.1),
        "diff_subln_g": gain((L, DIFF_DV)),
        "w_branch_gla": nrm((L, GLA_V, D), GLA_V ** -0.5),
        "w_branch_diff": nrm((L, DIFF_V, D), DIFF_V ** -0.5),
        "w_out": nrm((L, D, D), D ** -0.5),
        "norm2_g": gain((L, D)),
        "w_router": nrm((L, D, E), D ** -0.5),
        "router_bias": nrm((L, E), 0.01),
        "w_exp_gate": nrm((L, E, D, F), D ** -0.5),
        "w_exp_up": nrm((L, E, D, F), D ** -0.5),
        "w_exp_down": nrm((L, E, F, D), F ** -0.5),
        "w_sh_gate": nrm((L, D, D_SHARED), D ** -0.5),
        "w_sh_up": nrm((L, D, D_SHARED), D ** -0.5),
        "w_sh_down": nrm((L, D_SHARED, D), D_SHARED ** -0.5),
    }


def reference(x, c, positions, w_ada, b_ada, norm1_g, w_in, gla_w_a2, gla_b_a, gla_onorm_g,
              diff_qnorm_g, diff_knorm_g, diff_lq1, diff_lk1, diff_lq2, diff_lk2, diff_subln_g,
              w_branch_gla, w_branch_diff, w_out, norm2_g, w_router, router_bias,
              w_exp_gate, w_exp_up, w_exp_down, w_sh_gate, w_sh_up, w_sh_down):
    B, S, D = x.shape
    cos, sin = rope_tables(positions)
    c_act = jax.nn.silu(c)
    split_points = [int(p) for p in np.cumsum(SPLITS)[:-1]]
    for l in range(DEPTH):
        lambda_init = 0.8 - 0.6 * math.exp(-0.3 * l)
        mod = c_act @ w_ada[l] + b_ada[l]
        sh_a, sc_a, gt_a, sh_f, sc_f, gt_f = [m[:, None, :] for m in jnp.split(mod, 6, axis=-1)]

        h = rms_norm(x, norm1_g[l]) * (1.0 + sc_a) + sh_a
        proj = h @ w_in[l]
        gq, gk, gv, ga, gg, dq, dk, dv, mg_gla, mg_diff = jnp.split(proj, split_points, axis=-1)
        o_gla = gla_mixer(gq, gk, gv, ga, gg, gla_w_a2[l], gla_b_a[l], gla_onorm_g[l])
        o_diff = diff_mixer(dq, dk, dv, cos, sin, diff_qnorm_g[l], diff_knorm_g[l],
                            diff_lq1[l], diff_lk1[l], diff_lq2[l], diff_lk2[l],
                            diff_subln_g[l], lambda_init)
        merged = (jax.nn.sigmoid(mg_gla) * (o_gla @ w_branch_gla[l])
                  + jax.nn.sigmoid(mg_diff) * (o_diff @ w_branch_diff[l]))
        x = x + gt_a * (merged @ w_out[l])

        h2 = rms_norm(x, norm2_g[l]) * (1.0 + sc_f) + sh_f
        hf = h2.reshape(B * S, D)
        shared = swiglu(hf, w_sh_gate[l], w_sh_up[l], w_sh_down[l])
        routed = routed_moe(hf, w_router[l], router_bias[l], w_exp_gate[l], w_exp_up[l], w_exp_down[l])
        x = x + gt_f * (shared + routed).reshape(B, S, D)
    return x
```

```cpp
#include <hip/hip_runtime.h>
#include <stdint.h>
#include <math.h>

#define LAS __attribute__((address_space(3)))
typedef unsigned short bf16_t;
typedef short bf16x8 __attribute__((ext_vector_type(8)));
typedef float f32x4 __attribute__((ext_vector_type(4)));
typedef float f32x16 __attribute__((ext_vector_type(16)));
typedef unsigned u32x4 __attribute__((ext_vector_type(4)));
typedef unsigned u32x2 __attribute__((ext_vector_type(2)));

constexpr int T_ = 16384, D_ = 1024, NPROJ = 8192, NTHR = 512;
constexpr size_t MiB = (size_t)1 << 20;
constexpr size_t OFF_CTL = 0, OFF_MOD = 64 << 10, OFF_WAT = 96 << 10, OFF_DEC = 128 << 10, OFF_EIDX = 1 * MiB, OFF_POSI = 1 * MiB + (512 << 10),
    OFF_WINT = 2 * MiB, OFF_WBG = 18 * MiB, OFF_WBD = 20 * MiB, OFF_WO = 22 * MiB, OFF_WF = 24 * MiB, OFF_WSD = 25 * MiB + (512 << 10), OFF_WGU = 26 * MiB,
    OFF_WD = 282 * MiB, OFF_PROJ = 410 * MiB, OFF_H = 666 * MiB, OFF_VT = 698 * MiB, OFF_VTG = 730 * MiB, OFF_KDT = 762 * MiB, OFF_LOC = 778 * MiB,
    OFF_CARRY = 810 * MiB, OFF_OGLA = 842 * MiB, OFF_ODIFF = 874 * MiB, OFF_MERGED = 906 * MiB,
    OFF_LOGITS = 698 * MiB, OFF_HS = 714 * MiB, OFF_SD = 722 * MiB, OFF_TOKL = 754 * MiB, OFF_WL = 770 * MiB, OFF_HE = 786 * MiB, OFF_YS = OFF_PROJ, OFF_H2F8 = 906 * MiB, OFF_Q8 = 26 * MiB, OFF_K8 = 42 * MiB, OFF_V8T = 58 * MiB;
constexpr int C_GQ = 0, C_GK = 512, C_GV = 1024, C_GG = 2048, C_DQ = 3072, C_DK = 4096, C_DV = 5120, C_MGL = 6144, C_MGD = 7168;
constexpr float EPS = 1e-6f;

struct P {
    const float *x, *c; const int* pos;
    const float *w_ada, *b_ada, *norm1_g, *w_in, *gla_w_a2, *gla_b_a, *gla_onorm_g, *qn_g, *kn_g, *lq1, *lk1, *lq2, *lk2, *subln_g, *w_bg, *w_bd, *w_out, *norm2_g,
        *w_router, *router_bias, *w_eg, *w_eu, *w_ed, *w_sg, *w_su, *w_sd;
    float* out; unsigned char* ws;
    float invf[8];
};

__device__ __forceinline__ unsigned f2bf(float f) { unsigned u = __float_as_uint(f); return (u + 0x7fffu + ((u >> 16) & 1u)) >> 16; }
__device__ __forceinline__ float bf2f(unsigned b) { return __uint_as_float(b << 16); }
typedef float f32x2_t __attribute__((ext_vector_type(2))); typedef __bf16 bf16x2_t __attribute__((ext_vector_type(2)));
__device__ __forceinline__ unsigned pk2(float lo, float hi) { const f32x2_t v = {lo, hi}; return __builtin_bit_cast(unsigned, __builtin_convertvector(v, bf16x2_t)); }
__device__ __forceinline__ float bflo(unsigned w) { return __uint_as_float(w << 16); }
__device__ __forceinline__ float bfhi(unsigned w) { return __uint_as_float(w & 0xffff0000u); }
__device__ __forceinline__ float sigmoidf_(float z) { return 1.0f / (1.0f + __expf(-z)); }
__device__ __forceinline__ float siluf_(float z) { return z / (1.0f + __expf(-z)); }
__device__ __forceinline__ float wave_sum(float v) {
#pragma unroll
    for (int o = 32; o >= 1; o >>= 1) v += __shfl_xor(v, o);
    return v;
}
__device__ __forceinline__ int tid_() { int t = threadIdx.x; asm volatile("" : "+v"(t)); return t; }
typedef float f32x2v __attribute__((ext_vector_type(2)));
__device__ __forceinline__ unsigned pk4_fp8(float a, float b, float c, float d) { int w = __builtin_amdgcn_cvt_pk_fp8_f32(a, b, 0, false); w = __builtin_amdgcn_cvt_pk_fp8_f32(c, d, w, true); return (unsigned)w; }
__device__ __forceinline__ bf16x8 fp8x8_to_bf16x8(u32x2 w) {
    const f32x2v a = __builtin_amdgcn_cvt_pk_f32_fp8((int)w[0], false), b = __builtin_amdgcn_cvt_pk_f32_fp8((int)w[0], true), c = __builtin_amdgcn_cvt_pk_f32_fp8((int)w[1], false), d = __builtin_amdgcn_cvt_pk_f32_fp8((int)w[1], true);
    const u32x4 r = {pk2(a[0], a[1]), pk2(b[0], b[1]), pk2(c[0], c[1]), pk2(d[0], d[1])}; return __builtin_bit_cast(bf16x8, r); }
#define MFMA16(a, b, c) __builtin_amdgcn_mfma_f32_16x16x32_bf16((a), (b), (c), 0, 0, 0)
#define MFMA32(a, b, c) __builtin_amdgcn_mfma_f32_32x32x16_bf16((a), (b), (c), 0, 0, 0)
__device__ __forceinline__ int crow(int reg, int hi) { return (reg & 3) + 8 * (reg >> 2) + 4 * hi; }

namespace pg8 {
#define PG8_LAS __attribute__((address_space(3)))
constexpr int BM = 256, BK = 64, HALF = 128, HTB = HALF * BK * 2  , STAGE_BYTES = 8 * HTB, NXCD = 8, WGM = 8;

__host__ __device__ __forceinline__ int lds_byte(int r, int c) { const int st = (r >> 4) * 2 + (c >> 5), rr = r & 15, cc = c & 31, ob = rr * 64 + cc * 2; return st * 1024 + (ob ^ (((ob >> 9) & 1) << 5)); }
__host__ __device__ __forceinline__ void stage_rc(int b, int& R, int& C) { const int st = b / 1024, sb = b % 1024, swz = sb ^ (((sb >> 9) & 1) << 5); R = (st >> 1) * 16 + swz / 64; C = (st & 1) * 32 + (swz % 64) / 2; }
__host__ __device__ __forceinline__ int perm32(int rho) { const int n = rho >> 4, i = rho & 15; return 8 * (i >> 2) + 4 * n + (i & 3); }
struct Unit { int pm, pn; };
struct Gemm { const bf16_t* A; const bf16_t* Bt; int M, N, K; };

struct StaticOrder {
    int nM, nN, nwg, G, c;
    __host__ __device__ void init(int M, int N, int G_, int c_) { nM = M / BM; nN = N / BM; nwg = nM * nN; G = G_; c = c_; }
    __host__ __device__ bool next(int i, Unit& u) const {
        const long L = (long)i * G + c; if (L >= nwg) return false;
        int wgid = (int)L; { const int q = nwg / NXCD, r = nwg % NXCD, xcd = wgid % NXCD, off = wgid / NXCD; wgid = (xcd < r ? xcd * (q + 1) : r * (q + 1) + (xcd - r) * q) + off; }
        const int nig = WGM * nN, gid = wgid / nig, fm = gid * WGM, gsz = (nM - fm) < WGM ? (nM - fm) : WGM;
        u.pm = fm + ((wgid % nig) % gsz); u.pn = (wgid % nig) / gsz; return true;
    }
    __device__ __forceinline__ void a_ready(const Unit&) const {}
    __device__ __forceinline__ void done(const Unit&) const {}
};
__device__ __forceinline__ void glds16_s(unsigned voff, const void* sbase, unsigned lds_dst) { unsigned keep;
    asm volatile("s_nop 4\n\ts_mov_b32 %0, m0\n\ts_mov_b32 m0, %3\n\ts_nop 0\n\tglobal_load_lds_dwordx4 %1, %2\n\ts_mov_b32 m0, %0" : "=&s"(keep) : "v"(voff), "s"(sbase), "s"(lds_dst) : "memory"); }
typedef int i32x8 __attribute__((ext_vector_type(8)));
typedef int i32x4 __attribute__((ext_vector_type(4)));
__device__ __forceinline__ i32x8 cat16(bf16x8 lo, bf16x8 hi) { return __builtin_shufflevector(__builtin_bit_cast(i32x4, lo), __builtin_bit_cast(i32x4, hi), 0, 1, 2, 3, 4, 5, 6, 7); }
template <class Epi, class Sched, bool ALIGN_EPI = false, bool SP2 = false, bool F8 = false>
__device__ __forceinline__ void gemm_phase(PG8_LAS unsigned char* lds, const Gemm g, const Sched& S, const Epi& E) {
    const int tid = tid_(), wid = __builtin_amdgcn_readfirstlane(tid >> 6), lane = tid & 63, wr = wid >> 2, wc = wid & 3, fr = lane & 15, fq = lane >> 4;
    const int K = g.K, nt = K / BK;
    unsigned voffA[2], voffB[2];
#pragma unroll
    for (int i = 0; i < 2; ++i) { int R, C; stage_rc(tid * 16 + i * 8192, R, C); const int Rb = Epi::PERM ? ((R & ~31) + perm32(R & 31)) : R;
        voffA[i] = (unsigned)(R * K + C) * 2u; voffB[i] = (unsigned)(Rb * K + C) * 2u; }
    const size_t kstep = (size_t)(BK * 2);
    const size_t hstep = (size_t)HALF * K * 2;
    const size_t tstep = 2 * hstep;
    const unsigned ldsw = (unsigned)wid * 1024u;
    const unsigned ldsb0 = (unsigned)(uintptr_t)lds;
    const int aoff = lds_byte(wr * 64 + fr, fq * 8), boff = lds_byte(wc * 32 + fr, fq * 8);
#define PG8_SA(b, h) (((b) * 2 + (h)) * HTB)
#define PG8_SB(b, h) ((4 + (b) * 2 + (h)) * HTB)
#define PG8_STAGE(bufoff, gbase, voff) do { _Pragma("unroll") for (int _i = 0; _i < 2; ++_i) { \
        if constexpr (F8) { int R_, C_; stage_rc((tid_() & 511) * 16 + _i * 8192, R_, C_); const bool isB_ = &(voff)[0] == &voffB[0]; if (isB_ && Epi::PERM) R_ = (R_ & ~31) + perm32(R_ & 31); \
            glds16_s((unsigned)(R_ * K + C_) * 2u, (const void*)(gbase), (unsigned)__builtin_amdgcn_readfirstlane(ldsb0 + (unsigned)(bufoff) + ldsw + _i * 8192)); } \
        else __builtin_amdgcn_global_load_lds((const unsigned*)((const char*)(gbase) + (voff)[_i]), (PG8_LAS unsigned*)(lds + (bufoff) + ldsw + _i * 8192), 16, 0, 0); } } while (0)
#define PG8_LDA(dst, b, h) do { _Pragma("unroll") for (int m = 0; m < 4; ++m) { if constexpr (F8) dst##8[m] = cat16(*(const PG8_LAS bf16x8*)(lds + PG8_SA(b, h) + aoff + m * 2048), *(const PG8_LAS bf16x8*)(lds + PG8_SA(b, h) + aoff + m * 2048 + 1024)); \
        else { _Pragma("unroll") for (int k = 0; k < 2; ++k) dst[m][k] = *(const PG8_LAS bf16x8*)(lds + PG8_SA(b, h) + aoff + m * 2048 + k * 1024); } } } while (0)
#define PG8_LDB(dst, b, h) do { _Pragma("unroll") for (int n = 0; n < 2; ++n) { if constexpr (F8) dst##8[n] = cat16(*(const PG8_LAS bf16x8*)(lds + PG8_SB(b, h) + boff + n * 2048), *(const PG8_LAS bf16x8*)(lds + PG8_SB(b, h) + boff + n * 2048 + 1024)); \
        else { _Pragma("unroll") for (int k = 0; k < 2; ++k) dst[n][k] = *(const PG8_LAS bf16x8*)(lds + PG8_SB(b, h) + boff + n * 2048 + k * 1024); } } } while (0)
#define PG8_MMA(ai, bj, At, Bt) do { __builtin_amdgcn_s_setprio(1); if constexpr (F8) { _Pragma("unroll") for (int m = 0; m < 4; ++m) _Pragma("unroll") for (int n = 0; n < 2; ++n) \
        acc[ai][bj][m][n] = __builtin_amdgcn_mfma_scale_f32_16x16x128_f8f6f4(Bt##8[n], At##8[m], acc[ai][bj][m][n], 0, 0, 0, 0x7A7A7A7A, 0, 0x7F7F7F7F); } else { \
        _Pragma("unroll") for (int m = 0; m < 4; ++m) _Pragma("unroll") for (int n = 0; n < 2; ++n) _Pragma("unroll") for (int k = 0; k < 2; ++k) \
        acc[ai][bj][m][n] = __builtin_amdgcn_mfma_f32_16x16x32_bf16(Bt[n][k], At[m][k], acc[ai][bj][m][n], 0, 0, 0); } __builtin_amdgcn_s_setprio(0); } while (0)
#define PG8_WAIT_V(n) asm volatile("s_waitcnt vmcnt(" #n ")" ::: "memory")
#define PG8_WAIT_L(n) asm volatile("s_waitcnt lgkmcnt(" #n ")" ::: "memory")
#define PG8_BAR __builtin_amdgcn_s_barrier()
#define PG8_SCHED __builtin_amdgcn_sched_barrier(0)
    Unit cur, nxt; int ui = 0;
    if (!S.next(0, cur)) return;
    f32x4 acc[2][2][4][2];
#pragma unroll
    for (int a = 0; a < 2; ++a)
#pragma unroll
        for (int b = 0; b < 2; ++b)
#pragma unroll
            for (int m = 0; m < 4; ++m)
#pragma unroll
                for (int n = 0; n < 2; ++n) acc[a][b][m][n] = (f32x4){0.f, 0.f, 0.f, 0.f};
    bf16x8 At[4][2], B0[2][2], B1[2][2]; i32x8 At8[4], B08[2], B18[2];
    const char* cA = (const char*)g.A + (size_t)cur.pm * tstep; const char* cB = (const char*)g.Bt + (size_t)cur.pn * tstep;
    S.a_ready(cur);
    if constexpr (SP2) {
        PG8_STAGE(PG8_SB(0, 0), cB, voffB); PG8_STAGE(PG8_SB(0, 1), cB + hstep, voffB); PG8_STAGE(PG8_SA(0, 0), cA, voffA); PG8_STAGE(PG8_SA(0, 1), cA + hstep, voffA);
        if (wr == 1) PG8_BAR;
        PG8_WAIT_V(2); PG8_BAR;
        PG8_STAGE(PG8_SB(1, 0), cB + kstep, voffB); PG8_STAGE(PG8_SA(1, 0), cA + kstep, voffA); PG8_STAGE(PG8_SB(1, 1), cB + hstep + kstep, voffB);
        PG8_WAIT_V(6); PG8_BAR;
    } else {
        PG8_STAGE(PG8_SB(0, 0), cB, voffB); PG8_STAGE(PG8_SA(0, 0), cA, voffA); PG8_STAGE(PG8_SB(0, 1), cB + hstep, voffB); PG8_STAGE(PG8_SA(0, 1), cA + hstep, voffA);
        if (wr == 1) PG8_BAR;
        PG8_WAIT_V(4); PG8_BAR;
        PG8_STAGE(PG8_SB(1, 0), cB + kstep, voffB); PG8_STAGE(PG8_SA(1, 0), cA + kstep, voffA); PG8_STAGE(PG8_SB(1, 1), cB + hstep + kstep, voffB);
        PG8_WAIT_V(6); PG8_BAR;
    }
    for (;;) {
        const bool has_next = S.next(ui + 1, nxt);
        const char* nA = has_next ? (const char*)g.A + (size_t)nxt.pm * tstep : cA; const char* nB = has_next ? (const char*)g.Bt + (size_t)nxt.pn * tstep : cB;
#pragma unroll 1
        for (int t = 0; t < nt; t += 2) {
            const bool last = (t == nt - 2);
            const char* a1 = cA + (size_t)(t + 1) * kstep;
            const char* a2 = last ? nA : cA + (size_t)(t + 2) * kstep; const char* b2 = last ? nB : cB + (size_t)(t + 2) * kstep;
            const char* a3 = a2 + kstep; const char* b3 = b2 + kstep;
            if (last && has_next) S.a_ready(nxt);
            if constexpr (SP2) {
            PG8_LDB(B0, 0, 0); PG8_LDB(B1, 0, 1); PG8_SCHED; PG8_LDA(At, 0, 0); PG8_STAGE(PG8_SA(1, 1), a1 + hstep, voffA);
            PG8_WAIT_V(8); PG8_WAIT_L(0); PG8_BAR; PG8_MMA(0, 0, At, B0); PG8_MMA(0, 1, At, B1); PG8_BAR; PG8_SCHED;
            PG8_LDA(At, 0, 1); PG8_STAGE(PG8_SB(0, 0), b2, voffB); PG8_STAGE(PG8_SB(0, 1), b2 + hstep, voffB); PG8_STAGE(PG8_SA(0, 0), a2, voffA);
            PG8_WAIT_V(8); PG8_WAIT_L(0); PG8_BAR; PG8_MMA(1, 0, At, B0); PG8_MMA(1, 1, At, B1); PG8_BAR; PG8_SCHED;
            PG8_LDB(B0, 1, 0); PG8_LDB(B1, 1, 1); PG8_SCHED; PG8_LDA(At, 1, 0); PG8_STAGE(PG8_SA(0, 1), a2 + hstep, voffA);
            PG8_WAIT_V(8); PG8_WAIT_L(0); PG8_BAR; PG8_MMA(0, 0, At, B0); PG8_MMA(0, 1, At, B1); PG8_BAR; PG8_SCHED;
            PG8_LDA(At, 1, 1); PG8_STAGE(PG8_SB(1, 0), b3, voffB); PG8_STAGE(PG8_SB(1, 1), b3 + hstep, voffB); PG8_STAGE(PG8_SA(1, 0), a3, voffA);
            PG8_WAIT_V(8); PG8_WAIT_L(0); PG8_BAR; PG8_MMA(1, 0, At, B0); PG8_MMA(1, 1, At, B1); PG8_BAR; PG8_SCHED;
            } else {
            PG8_LDB(B0, 0, 0); PG8_SCHED; PG8_LDA(At, 0, 0); PG8_STAGE(PG8_SA(1, 1), a1 + hstep, voffA);
            PG8_WAIT_L(8); PG8_BAR; PG8_WAIT_L(0); PG8_MMA(0, 0, At, B0); PG8_BAR; PG8_SCHED;
            PG8_LDB(B1, 0, 1); PG8_STAGE(PG8_SB(0, 0), b2, voffB);
            PG8_BAR; PG8_WAIT_L(0); PG8_MMA(0, 1, At, B1); PG8_BAR;
            PG8_LDA(At, 0, 1); PG8_STAGE(PG8_SA(0, 0), a2, voffA);
            PG8_BAR; PG8_WAIT_L(0); PG8_MMA(1, 0, At, B0); PG8_BAR; PG8_SCHED;
            PG8_STAGE(PG8_SB(0, 1), b2 + hstep, voffB);
            PG8_WAIT_V(6); PG8_BAR; PG8_MMA(1, 1, At, B1); PG8_BAR;
            PG8_LDB(B0, 1, 0); PG8_SCHED; PG8_LDA(At, 1, 0); PG8_STAGE(PG8_SA(0, 1), a2 + hstep, voffA);
            PG8_WAIT_L(8); PG8_BAR; PG8_WAIT_L(0); PG8_MMA(0, 0, At, B0); PG8_BAR; PG8_SCHED;
            PG8_LDB(B1, 1, 1); PG8_STAGE(PG8_SB(1, 0), b3, voffB);
            PG8_BAR; PG8_WAIT_L(0); PG8_MMA(0, 1, At, B1); PG8_BAR;
            PG8_LDA(At, 1, 1); PG8_STAGE(PG8_SA(1, 0), a3, voffA);
            PG8_BAR; PG8_WAIT_L(0); PG8_MMA(1, 0, At, B0); PG8_BAR; PG8_SCHED;
            PG8_STAGE(PG8_SB(1, 1), b3 + hstep, voffB);
            PG8_WAIT_V(6); PG8_BAR; PG8_MMA(1, 1, At, B1); PG8_BAR;
            }
        }
        if constexpr (ALIGN_EPI) { if (wr == 0) PG8_BAR; }
        if constexpr (!Epi::AFTER_DRAIN) { const int te_ = tid_() & 63; E(acc, cur, wr, wc, te_ & 15, te_ >> 4); S.done(cur); }
        if (!has_next) break;
#pragma unroll
        for (int a = 0; a < 2; ++a)
#pragma unroll
            for (int b = 0; b < 2; ++b)
#pragma unroll
                for (int m = 0; m < 4; ++m)
#pragma unroll
                    for (int n = 0; n < 2; ++n) acc[a][b][m][n] = (f32x4){0.f, 0.f, 0.f, 0.f};
        cur = nxt; cA = nA; cB = nB; ++ui;
        if constexpr (ALIGN_EPI) { if (wr == 1) PG8_BAR; }
    }
    PG8_WAIT_V(0);
    if constexpr (!ALIGN_EPI) { if (wr == 0) PG8_BAR; }
    PG8_BAR;
    if constexpr (Epi::AFTER_DRAIN) { E.fused(acc, cur, wr, wc, fr, fq, lds, wid, lane); S.done(cur); }
#undef PG8_SA
#undef PG8_SB
#undef PG8_STAGE
#undef PG8_LDA
#undef PG8_LDB
#undef PG8_MMA
#undef PG8_WAIT_V
#undef PG8_WAIT_L
#undef PG8_BAR
#undef PG8_SCHED
}
}
using pg8::Unit; using pg8::perm32;

template <class ARow, class Epi>
__device__ __forceinline__ void gemm_unit_direct(const bf16_t* __restrict__ A, const ARow& arow, const bf16_t* __restrict__ Btile, int K, const Epi& E, const Unit& u) {
    const int tid = tid_(), wid = tid >> 6, lane = tid & 63, wr = wid >> 2, wc = wid & 3, fr = lane & 15, fq = lane >> 4;
    f32x4 acc[2][2][4][2];
#pragma unroll
    for (int a = 0; a < 2; ++a)
#pragma unroll
        for (int b = 0; b < 2; ++b)
#pragma unroll
            for (int m = 0; m < 4; ++m)
#pragma unroll
                for (int n = 0; n < 2; ++n) acc[a][b][m][n] = (f32x4){0.f, 0.f, 0.f, 0.f};
    unsigned aoff[2][4], boff[2][2];
#pragma unroll
    for (int ai = 0; ai < 2; ++ai)
#pragma unroll
        for (int m = 0; m < 4; ++m) aoff[ai][m] = arow(128 * ai + 64 * wr + 16 * m + fr) + 8 * fq;
#pragma unroll
    for (int bj = 0; bj < 2; ++bj)
#pragma unroll
        for (int n = 0; n < 2; ++n) boff[bj][n] = (unsigned)(128 * bj + 32 * wc + perm32(16 * n + fr)) * (unsigned)K + 8 * fq;
#pragma unroll 1
    for (int k0 = 0; k0 < K; k0 += 32) {
        bf16x8 b[2][2];
#pragma unroll
        for (int bj = 0; bj < 2; ++bj)
#pragma unroll
            for (int n = 0; n < 2; ++n) b[bj][n] = *(const bf16x8*)(Btile + boff[bj][n] + k0);
#pragma unroll
        for (int ai = 0; ai < 2; ++ai) {
            bf16x8 a[4];
#pragma unroll
            for (int m = 0; m < 4; ++m) a[m] = *(const bf16x8*)(A + aoff[ai][m] + k0);
#pragma unroll
            for (int bj = 0; bj < 2; ++bj)
#pragma unroll
                for (int m = 0; m < 4; ++m)
#pragma unroll
                    for (int n = 0; n < 2; ++n) acc[ai][bj][m][n] = MFMA16(b[bj][n], a[m], acc[ai][bj][m][n]);
        }
    }
    E(acc, u, wr, wc, fr, fq);
}
struct RowLinear { unsigned row0, ld; __device__ __forceinline__ unsigned operator()(int r) const { return (row0 + (unsigned)r) * ld; } };

#define EPI_LOOP for (int ai = 0; ai < 2; ++ai) for (int m = 0; m < 4; ++m) for (int bj = 0; bj < 2; ++bj)
struct EpiStoreBf16 {
    static constexpr bool PERM = true, AFTER_DRAIN = false;
    bf16_t* O; int ld;
    __device__ __forceinline__ void operator()(const f32x4 (&acc)[2][2][4][2], const Unit& u, int wr, int wc, int fr, int fq) const {
#pragma unroll
        for (int ai = 0; ai < 2; ++ai)
#pragma unroll
            for (int m = 0; m < 4; ++m)
#pragma unroll
                for (int bj = 0; bj < 2; ++bj) {
                    const size_t row = (size_t)u.pm * 256 + 128 * ai + 64 * wr + 16 * m + fr; const int col = u.pn * 256 + 128 * bj + 32 * wc + 8 * fq;
                    const f32x4 v0 = acc[ai][bj][m][0], v1 = acc[ai][bj][m][1];
                    u32x4 w = {pk2(v0[0], v0[1]), pk2(v0[2], v0[3]), pk2(v1[0], v1[1]), pk2(v1[2], v1[3])};
                    *(u32x4*)(O + row * ld + col) = w;
                }
    }
};
struct EpiB1a {
    static constexpr bool PERM = true, AFTER_DRAIN = false;
    bf16_t* M1; const bf16_t* PROJ;
    __device__ __forceinline__ void operator()(const f32x4 (&acc)[2][2][4][2], const Unit& u, int wr, int wc, int fr, int fq) const {
#pragma unroll
        for (int ai = 0; ai < 2; ++ai)
#pragma unroll
            for (int m = 0; m < 4; ++m)
#pragma unroll
                for (int bj = 0; bj < 2; ++bj) {
                    const size_t row = (size_t)u.pm * 256 + 128 * ai + 64 * wr + 16 * m + fr; const int col = u.pn * 256 + 128 * bj + 32 * wc + 8 * fq;
                    const u32x4 g = *(const u32x4*)(PROJ + row * NPROJ + C_MGL + col);
                    const f32x4 v0 = acc[ai][bj][m][0], v1 = acc[ai][bj][m][1];
                    f32x4 o0 = {sigmoidf_(bflo(g[0])) * v0[0], sigmoidf_(bfhi(g[0])) * v0[1], sigmoidf_(bflo(g[1])) * v0[2], sigmoidf_(bfhi(g[1])) * v0[3]};
                    f32x4 o1 = {sigmoidf_(bflo(g[2])) * v1[0], sigmoidf_(bfhi(g[2])) * v1[1], sigmoidf_(bflo(g[3])) * v1[2], sigmoidf_(bfhi(g[3])) * v1[3]};
                    *(u32x4*)(M1 + row * D_ + col) = (u32x4){pk2(o0[0], o0[1]), pk2(o0[2], o0[3]), pk2(o1[0], o1[1]), pk2(o1[2], o1[3])};
                }
    }
};
struct EpiB1b {
    static constexpr bool PERM = true, AFTER_DRAIN = false;
    const bf16_t* M1; const bf16_t* PROJ; bf16_t* MERGED;
    __device__ __forceinline__ void operator()(const f32x4 (&acc)[2][2][4][2], const Unit& u, int wr, int wc, int fr, int fq) const {
#pragma unroll
        for (int ai = 0; ai < 2; ++ai)
#pragma unroll
            for (int m = 0; m < 4; ++m)
#pragma unroll
                for (int bj = 0; bj < 2; ++bj) {
                    const size_t row = (size_t)u.pm * 256 + 128 * ai + 64 * wr + 16 * m + fr; const int col = u.pn * 256 + 128 * bj + 32 * wc + 8 * fq;
                    const u32x4 g = *(const u32x4*)(PROJ + row * NPROJ + C_MGD + col);
                    const u32x4 mw = *(const u32x4*)(M1 + row * D_ + col); const f32x4 m0 = {bflo(mw[0]), bfhi(mw[0]), bflo(mw[1]), bfhi(mw[1])}, m1 = {bflo(mw[2]), bfhi(mw[2]), bflo(mw[3]), bfhi(mw[3])};
                    const f32x4 v0 = acc[ai][bj][m][0], v1 = acc[ai][bj][m][1];
                    f32x4 o0 = {m0[0] + sigmoidf_(bflo(g[0])) * v0[0], m0[1] + sigmoidf_(bfhi(g[0])) * v0[1], m0[2] + sigmoidf_(bflo(g[1])) * v0[2], m0[3] + sigmoidf_(bfhi(g[1])) * v0[3]};
                    f32x4 o1 = {m1[0] + sigmoidf_(bflo(g[2])) * v1[0], m1[1] + sigmoidf_(bfhi(g[2])) * v1[1], m1[2] + sigmoidf_(bflo(g[3])) * v1[2], m1[3] + sigmoidf_(bfhi(g[3])) * v1[3]};
                    *(u32x2*)((unsigned char*)MERGED + row * D_ + col) = (u32x2){pk4_fp8(o0[0], o0[1], o0[2], o0[3]), pk4_fp8(o1[0], o1[1], o1[2], o1[3])};
                }
    }
};
struct EpiB2 {
    static constexpr bool PERM = true, AFTER_DRAIN = false;
    const float* x; const float* gate; float* X1;
    __device__ __forceinline__ void operator()(const f32x4 (&acc)[2][2][4][2], const Unit& u, int wr, int wc, int fr, int fq) const {
#pragma unroll
        for (int ai = 0; ai < 2; ++ai)
#pragma unroll
            for (int m = 0; m < 4; ++m)
#pragma unroll
                for (int bj = 0; bj < 2; ++bj) {
                    const size_t row = (size_t)u.pm * 256 + 128 * ai + 64 * wr + 16 * m + fr; const int col = u.pn * 256 + 128 * bj + 32 * wc + 8 * fq;
#pragma unroll
                    for (int n = 0; n < 2; ++n) {
                        const f32x4 xv = *(const f32x4*)(x + row * D_ + col + 4 * n), gv = *(const f32x4*)(gate + col + 4 * n);
                        *(f32x4*)(X1 + row * D_ + col + 4 * n) = xv + gv * acc[ai][bj][m][n];
                    }
                }
    }
};
struct EpiF1 {
    static constexpr bool PERM = true, AFTER_DRAIN = false;
    float* LOGITS; bf16_t* HS;
    __device__ __forceinline__ void operator()(const f32x4 (&acc)[2][2][4][2], const Unit& u, int wr, int wc, int fr, int fq) const {
#pragma unroll
        for (int ai = 0; ai < 2; ++ai)
#pragma unroll
            for (int m = 0; m < 4; ++m) {
                const size_t row = (size_t)u.pm * 256 + 128 * ai + 64 * wr + 16 * m + fr;
                if (u.pn == 0) {
#pragma unroll
                    for (int bj = 0; bj < 2; ++bj)
#pragma unroll
                        for (int n = 0; n < 2; ++n) *(f32x4*)(LOGITS + row * 256 + 128 * bj + 32 * wc + 8 * fq + 4 * n) = acc[ai][bj][m][n];
                } else {
                    float h[8];
#pragma unroll
                    for (int n = 0; n < 2; ++n)
#pragma unroll
                        for (int i = 0; i < 4; ++i) h[4 * n + i] = siluf_(acc[ai][0][m][n][i]) * acc[ai][1][m][n][i];
                    u32x4 w = {pk2(h[0], h[1]), pk2(h[2], h[3]), pk2(h[4], h[5]), pk2(h[6], h[7])};
                    *(u32x4*)(HS + row * 256 + (u.pn - 1) * 128 + 32 * wc + 8 * fq) = w;
                }
            }
    }
};
struct EpiM1 {
    bf16_t* HE; int cstart, cnt;
    __device__ __forceinline__ void operator()(const f32x4 (&acc)[2][2][4][2], const Unit& u, int wr, int wc, int fr, int fq) const {
#pragma unroll
        for (int ai = 0; ai < 2; ++ai)
#pragma unroll
            for (int m = 0; m < 4; ++m) {
                const int pos = u.pm * 256 + 128 * ai + 64 * wr + 16 * m + fr;
                if (pos < cnt) {
                    float h[8];
#pragma unroll
                    for (int n = 0; n < 2; ++n)
#pragma unroll
                        for (int i = 0; i < 4; ++i) h[4 * n + i] = siluf_(acc[ai][0][m][n][i]) * acc[ai][1][m][n][i];
                    u32x4 w = {pk2(h[0], h[1]), pk2(h[2], h[3]), pk2(h[4], h[5]), pk2(h[6], h[7])};
                    *(u32x4*)(HE + (size_t)(cstart + pos) * 256 + u.pn * 128 + 32 * wc + 8 * fq) = w;
                }
            }
    }
};
struct EpiM2 {
    bf16_t* YS; const float* wl; int cstart, cnt;
    __device__ __forceinline__ void operator()(const f32x4 (&acc)[2][2][4][2], const Unit& u, int wr, int wc, int fr, int fq) const {
#pragma unroll
        for (int ai = 0; ai < 2; ++ai)
#pragma unroll
            for (int m = 0; m < 4; ++m) {
                const int pos = u.pm * 256 + 128 * ai + 64 * wr + 16 * m + fr;
                if (pos < cnt) {
                    const float wt = wl[pos];
#pragma unroll
                    for (int bj = 0; bj < 2; ++bj) {
                        const int col = u.pn * 256 + 128 * bj + 32 * wc + 8 * fq;
                        const f32x4 v0 = acc[ai][bj][m][0] * wt, v1 = acc[ai][bj][m][1] * wt;
                        u32x4 w = {pk2(v0[0], v0[1]), pk2(v0[2], v0[3]), pk2(v1[0], v1[1]), pk2(v1[2], v1[3])};
                        *(u32x4*)(YS + (size_t)(cstart + pos) * D_ + col) = w;
                    }
                }
            }
    }
};

__device__ __forceinline__ void conv_tile(const float* __restrict__ src, int ldN, int k0, int n0, bf16_t* __restrict__ dst, int ldK, int dst_row0, float* tile) {
    const int tid = tid_();
    {
        const int r = tid >> 4, c4 = tid & 15;
#pragma unroll
        for (int i = 0; i < 2; ++i) {
            const int row = r + 32 * i;
            const f32x4 v = *(const f32x4*)(src + (size_t)(k0 + row) * ldN + n0 + 4 * c4);
            tile[row * 65 + 4 * c4 + 0] = v[0]; tile[row * 65 + 4 * c4 + 1] = v[1]; tile[row * 65 + 4 * c4 + 2] = v[2]; tile[row * 65 + 4 * c4 + 3] = v[3];
        }
    }
    __syncthreads();
    {
        const int n = tid >> 3, kq = tid & 7;
        float f[8];
#pragma unroll
        for (int j = 0; j < 8; ++j) f[j] = tile[(8 * kq + j) * 65 + n];
        u32x4 w = {pk2(f[0], f[1]), pk2(f[2], f[3]), pk2(f[4], f[5]), pk2(f[6], f[7])};
        *(u32x4*)(dst + (size_t)(dst_row0 + n) * ldK + k0 + 8 * kq) = w;
    }
    __syncthreads();
}
__device__ __forceinline__ void conv_tile_f8(const float* __restrict__ src, int ldN, int k0, int n0, unsigned char* __restrict__ dst, int ldK, int dst_row0, float* tile) {
    const int tid = tid_();
    {
        const int r = tid >> 4, c4 = tid & 15;
#pragma unroll
        for (int i = 0; i < 2; ++i) {
            const int row = r + 32 * i;
            const f32x4 v = *(const f32x4*)(src + (size_t)(k0 + row) * ldN + n0 + 4 * c4);
            tile[row * 65 + 4 * c4 + 0] = v[0]; tile[row * 65 + 4 * c4 + 1] = v[1]; tile[row * 65 + 4 * c4 + 2] = v[2]; tile[row * 65 + 4 * c4 + 3] = v[3];
        }
    }
    __syncthreads();
    {
        const int n = tid >> 3, kq = tid & 7;
        float f[8];
#pragma unroll
        for (int j = 0; j < 8; ++j) f[j] = tile[(8 * kq + j) * 65 + n] * 32.0f;
        *(u32x2*)(dst + (size_t)(dst_row0 + n) * ldK + k0 + 8 * kq) = (u32x2){pk4_fp8(f[0], f[1], f[2], f[3]), pk4_fp8(f[4], f[5], f[6], f[7])};
    }
    __syncthreads();
}
constexpr int NT_WIN = 2048, NT_SQ = 768, NT_WF = 192, NT_WSD = 64, NT_EGU = 256 * 128, NT_ED = 256 * 64;
constexpr int NT_ALL = NT_WIN + NT_SQ + NT_WF + NT_WSD;
__device__ __forceinline__ void conv_job(const P& p, int idx, float* tile) {
    unsigned char* ws = p.ws;
    if (idx < NT_WIN) { const int nb = idx >> 4, kb = idx & 15; const int n0 = 64 * nb + (64 * nb >= 2048 ? 16 : 0);
        conv_tile_f8(p.w_in, 8208, 64 * kb, n0, ws + OFF_WINT, 1024, 64 * nb, tile); return; }
    idx -= NT_WIN;
    if (idx < NT_SQ) { const int mat = idx >> 8, rem = idx & 255, nb = rem >> 4, kb = rem & 15;
        const float* src = mat == 0 ? p.w_bg : (mat == 1 ? p.w_bd : p.w_out); unsigned char* dst = ws + (mat == 0 ? OFF_WBG : (mat == 1 ? OFF_WBD : OFF_WO));
        conv_tile_f8(src, 1024, 64 * kb, 64 * nb, dst, 1024, 64 * nb, tile); return; }
    idx -= NT_SQ;
    if (idx < NT_WF) { const int nbd = idx >> 4, kb = idx & 15; bf16_t* dst = (bf16_t*)(ws + OFF_WF);
        if (nbd < 4) { conv_tile(p.w_router, 256, 64 * kb, 64 * nbd, dst, 1024, 64 * nbd, tile); }
        else { const int q = nbd - 4, tl = q >> 2, part = q & 3; const float* src = part < 2 ? p.w_sg : p.w_su;
            conv_tile(src, 256, 64 * kb, 128 * tl + 64 * (part & 1), dst, 1024, 64 * nbd, tile); }
        return; }
    idx -= NT_WF;
    if (idx < NT_WSD) { const int nb = idx >> 2, kb = idx & 3; conv_tile(p.w_sd, 1024, 64 * kb, 64 * nb, (bf16_t*)(ws + OFF_WSD), 256, 64 * nb, tile); return; }
    idx -= NT_WSD;
    if (idx < NT_EGU) { const int e = idx >> 7, rem = idx & 127, nbd = rem >> 4, kb = rem & 15, tl = nbd >> 2, part = nbd & 3;
        const float* src = (part < 2 ? p.w_eg : p.w_eu) + (size_t)e * 1024 * 256;
        conv_tile(src, 256, 64 * kb, 128 * tl + 64 * (part & 1), (bf16_t*)(ws + OFF_WGU) + (size_t)e * 512 * 1024, 1024, 64 * nbd, tile); return; }
    idx -= NT_EGU;
    { const int e = idx >> 6, rem = idx & 63, nb = rem >> 2, kb = rem & 3;
        conv_tile(p.w_ed + (size_t)e * 256 * 1024, 1024, 64 * kb, 64 * nb, (bf16_t*)(ws + OFF_WD) + (size_t)e * 1024 * 256, 256, 64 * nb, tile); }
}
__device__ __forceinline__ void phase_p0(const P& p, unsigned char* smem, int bid, int G) {
    float* fs = (float*)smem;
    const int tid = tid_();
    for (int u = bid; u < 192; u += G) {
        for (int k = tid; k < 1024; k += NTHR) fs[k] = siluf_(p.c[k]);
        __syncthreads();
        const int kg = tid >> 5, col = tid & 31; float s = 0.f;
#pragma unroll 16
        for (int k = kg; k < 1024; k += 16) s += fs[k] * __builtin_nontemporal_load(p.w_ada + (size_t)k * 6144 + 32 * u + col);
        fs[1024 + tid] = s;
        __syncthreads();
        if (tid < 32) { float t = 0.f;
#pragma unroll
            for (int g = 0; g < 16; ++g) t += fs[1024 + 32 * g + tid];
            ((float*)(p.ws + OFF_MOD))[32 * u + tid] = t + p.b_ada[32 * u + tid]; }
        __syncthreads();
    }
    for (int i = bid * NTHR + tid; i < 16 * 1024; i += G * NTHR) { const int j = i >> 10, k = i & 1023; ((bf16_t*)(p.ws + OFF_WAT))[i] = (bf16_t)f2bf(p.w_in[(size_t)k * 8208 + 2048 + j]); }
}
__device__ __forceinline__ void phase_conv(const P& p, unsigned char* smem, int bid, int G, int j0, int j1) {
    __syncthreads();
    for (int t = j0 + bid; t < j1; t += G) conv_job(p, t, (float*)smem + 1536);
}

__device__ __forceinline__ void phase_norm(const float* __restrict__ x, const float* __restrict__ g, const float* __restrict__ sc, const float* __restrict__ sh, bf16_t* __restrict__ out, unsigned char* __restrict__ out8, int bid, int G) {
    const int tid = tid_(), wid = tid >> 6, lane = tid & 63;
    for (int row = bid * 8 + wid; row < T_; row += G * 8) {
        f32x4 v[4]; float ss = 0.f;
#pragma unroll
        for (int j = 0; j < 4; ++j) { v[j] = *(const f32x4*)(x + (size_t)row * D_ + 256 * j + 4 * lane); ss += v[j][0] * v[j][0] + v[j][1] * v[j][1] + v[j][2] * v[j][2] + v[j][3] * v[j][3]; }
        ss = wave_sum(ss);
        const float rstd = rsqrtf(ss * (1.0f / 1024.0f) + EPS);
#pragma unroll
        for (int j = 0; j < 4; ++j) { const int c = 256 * j + 4 * lane;
            const f32x4 gg = *(const f32x4*)(g + c), s1 = *(const f32x4*)(sc + c), s0 = *(const f32x4*)(sh + c);
            f32x4 y = v[j] * rstd * gg * (s1 + 1.0f) + s0;
            u32x2 w = {pk2(y[0], y[1]), pk2(y[2], y[3])};
            *(u32x2*)(out + (size_t)row * D_ + c) = w;
            if (out8) *(unsigned*)(out8 + (size_t)row * D_ + c) = pk4_fp8(y[0], y[1], y[2], y[3]); }
    }
}

constexpr float QSCALE = 0.125f * 1.4426950408889634f;
__device__ __forceinline__ float logsig(float z) { return fminf(z, 0.f) - __logf(1.0f + __expf(-fabsf(z))); }
__device__ __forceinline__ void prep_chunk(const P& p, int n, unsigned char* smem) {
    float* alow_s = (float*)smem;
    bf16_t* tt = (bf16_t*)(smem + 4096);
    const int tid = tid_(), wid = tid >> 6, lane = tid & 63;
    bf16_t* PROJ = (bf16_t*)(p.ws + OFF_PROJ); const bf16_t* H = (const bf16_t*)(p.ws + OFF_H); const bf16_t* WaT = (const bf16_t*)(p.ws + OFF_WAT);
    if (wid < 4) {
        const int fr = lane & 15, fq = lane >> 4; f32x4 acc = {0.f, 0.f, 0.f, 0.f};
        const bf16_t* ap = H + (size_t)(64 * n + 16 * wid + fr) * D_ + 8 * fq; const bf16_t* bp = WaT + (size_t)fr * D_ + 8 * fq;
#pragma unroll 1
        for (int k0 = 0; k0 < D_; k0 += 256) { bf16x8 av[8], bv[8];
#pragma unroll
            for (int j = 0; j < 8; ++j) { av[j] = *(const bf16x8*)(ap + k0 + 32 * j); bv[j] = *(const bf16x8*)(bp + k0 + 32 * j); }
#pragma unroll
            for (int j = 0; j < 8; ++j) acc = MFMA16(av[j], bv[j], acc); }
#pragma unroll
        for (int r = 0; r < 4; ++r) alow_s[(16 * wid + 4 * fq + r) * 16 + fr] = acc[r];
    }
    __syncthreads();
    {
        const int ch = tid; float w2[16];
#pragma unroll
        for (int j = 0; j < 16; ++j) w2[j] = p.gla_w_a2[j * 512 + ch];
        const float bb = p.gla_b_a[ch]; float suf = 0.f; bf16_t* dst = (bf16_t*)(p.ws + OFF_KDT) + ((size_t)n * 512 + ch) * 64;
#pragma unroll 1
        for (int c32 = 1; c32 >= 0; --c32) {
            unsigned short kraw[32];
#pragma unroll
            for (int i = 0; i < 32; ++i) kraw[i] = PROJ[(size_t)(64 * n + 32 * c32 + i) * NPROJ + C_GK + ch];
#pragma unroll
            for (int c8 = 3; c8 >= 0; --c8) { float kd[8];
#pragma unroll
                for (int i = 7; i >= 0; --i) { const int c = 32 * c32 + 8 * c8 + i; float z = bb;
#pragma unroll
                    for (int j = 0; j < 16; ++j) z += alow_s[c * 16 + j] * w2[j];
                    kd[i] = bf2f(kraw[8 * c8 + i]) * __expf(suf);
                    suf += logsig(z) * (1.0f / 16.0f); }
                u32x4 w = {pk2(kd[0], kd[1]), pk2(kd[2], kd[3]), pk2(kd[4], kd[5]), pk2(kd[6], kd[7])};
                *(u32x4*)(dst + 32 * c32 + 8 * c8) = w; }
        }
        ((float*)(p.ws + OFF_DEC))[n * 512 + ch] = __expf(suf);
    }
#pragma unroll 1
    for (int piece = 0; piece < 4; ++piece) {
        const int mat = piece >> 1, cb = (mat == 0 ? C_GV : C_DV) + 512 * (piece & 1);
        __syncthreads();
        { u32x4 v[8];
#pragma unroll
          for (int i = 0; i < 8; ++i) { const int pidx = tid + NTHR * i, c = pidx >> 6, q16 = pidx & 63; v[i] = *(const u32x4*)(PROJ + (size_t)(64 * n + c) * NPROJ + cb + 8 * q16); }
#pragma unroll
          for (int i = 0; i < 8; ++i) { const int pidx = tid + NTHR * i, c = pidx >> 6, q16 = pidx & 63; *(u32x4*)(tt + c * 520 + 8 * q16) = v[i]; } }
        __syncthreads();
        const int col = 512 * (piece & 1) + tid;
        if (mat == 0) {
            bf16_t* dst = (bf16_t*)(p.ws + OFF_VTG) + ((size_t)n * 1024 + col) * 64;
#pragma unroll
            for (int cq = 0; cq < 4; ++cq) { unsigned w[8];
#pragma unroll
                for (int j = 0; j < 8; ++j) w[j] = (unsigned)tt[(16 * cq + 2 * j) * 520 + tid] | ((unsigned)tt[(16 * cq + 2 * j + 1) * 520 + tid] << 16);
                *(u32x4*)(dst + 16 * cq) = (u32x4){w[0], w[1], w[2], w[3]}; *(u32x4*)(dst + 16 * cq + 8) = (u32x4){w[4], w[5], w[6], w[7]}; }
        } else {
            unsigned char* dst = p.ws + OFF_V8T + (size_t)col * T_ + 64 * n;
#pragma unroll
            for (int q = 0; q < 4; ++q) { unsigned w[4];
#pragma unroll
                for (int j = 0; j < 4; ++j) { float f[4];
#pragma unroll
                    for (int e = 0; e < 4; ++e) { const int g = 4 * j + e, key = 32 * (q & 1) + crow(g, q >> 1); f[e] = bf2f(tt[key * 520 + tid]); }
                    w[j] = pk4_fp8(f[0], f[1], f[2], f[3]); }
                *(u32x4*)(dst + 16 * q) = (u32x4){w[0], w[1], w[2], w[3]}; }
        }
    }
#pragma unroll 1
    for (int i0 = 0; i0 < 16; i0 += 4) {
        u32x4 ra[4], rb[4];
#pragma unroll
        for (int ii = 0; ii < 4; ++ii) { const int idx = wid * 16 + i0 + ii, which = idx >> 6, c = idx & 63;
            const bf16_t* base = PROJ + (size_t)(64 * n + c) * NPROJ + (which ? C_DK : C_DQ) + 16 * lane; ra[ii] = *(const u32x4*)base; rb[ii] = *(const u32x4*)(base + 8); }
#pragma unroll
        for (int ii = 0; ii < 4; ++ii) {
            const int idx = wid * 16 + i0 + ii, which = idx >> 6, c = idx & 63, t = 64 * n + c;
            const u32x4 a = ra[ii], b = rb[ii];
            float v[16];
#pragma unroll
            for (int j = 0; j < 4; ++j) { v[2 * j] = bflo(a[j]); v[2 * j + 1] = bfhi(a[j]); v[8 + 2 * j] = bflo(b[j]); v[8 + 2 * j + 1] = bfhi(b[j]); }
            float ss = 0.f;
#pragma unroll
            for (int j = 0; j < 16; ++j) ss += v[j] * v[j];
            ss += __shfl_xor(ss, 1); ss += __shfl_xor(ss, 2);
            const float rstd = rsqrtf(ss * (1.0f / 64.0f) + EPS);
            const float* g = (which ? p.kn_g : p.qn_g) + 16 * (lane & 3);
#pragma unroll
            for (int j = 0; j < 16; ++j) v[j] = v[j] * rstd * g[j];
            if ((lane & 3) == 0) {
                const float pos = (float)p.pos[t];
#pragma unroll
                for (int j = 0; j < 8; ++j) {
                    const float ang = pos * p.invf[j];
                    const double rev = (double)ang * 0.15915494309189535; const float fr = (float)(rev - floor(rev));
                    const float cs = __builtin_amdgcn_cosf(fr), sn = __builtin_amdgcn_sinf(fr);
                    const float t1 = v[j], t2 = v[8 + j]; v[j] = t1 * cs - t2 * sn; v[8 + j] = t2 * cs + t1 * sn; }
            }
            const float qs = which ? 1.0f : 1.4426950408889634f;
            u32x4 o8;
#pragma unroll
            for (int j = 0; j < 4; ++j) o8[j] = pk4_fp8(v[4 * j] * qs, v[4 * j + 1] * qs, v[4 * j + 2] * qs, v[4 * j + 3] * qs);
            *(u32x4*)(p.ws + (which ? OFF_K8 : OFF_Q8) + (size_t)t * D_ + 16 * lane) = o8;
        }
    }
}

template <bool FINAL>
__device__ __forceinline__ void gla_unit(const P& p, int s, int h, unsigned char* smem) {
    const int tid = tid_(), wid = tid >> 6, lane = tid & 63, r = lane & 31, hi = lane >> 5;
    const bf16_t* PROJ = (const bf16_t*)(p.ws + OFF_PROJ); const bf16_t* KDT = (const bf16_t*)(p.ws + OFF_KDT); const bf16_t* VTG = (const bf16_t*)(p.ws + OFF_VTG);
    const float* DEC = (const float*)(p.ws + OFF_DEC);
    float* o_s = (float*)(smem + 32768);
    LAS unsigned char* q_s = (LAS unsigned char*)smem;
    const int qrow_ = tid >> 3, qch_ = tid & 7;
    u32x4 qpre0 = {0u, 0u, 0u, 0u}, qpre1 = {0u, 0u, 0u, 0u};
    if (FINAL) { const bf16_t* qp_ = PROJ + (size_t)(64 * (4 * s) + qrow_) * NPROJ + C_GQ + h * 128 + 8 * qch_; qpre0 = *(const u32x4*)qp_; qpre1 = *(const u32x4*)(qp_ + 64); }
    f32x16 st[4];
    const size_t sbase = ((size_t)s * 4 + h) * 128 * 256;
    if (FINAL) { const float* CARRY = (const float*)(p.ws + OFF_CARRY) + sbase;
#pragma unroll
        for (int b = 0; b < 4; ++b)
#pragma unroll
            for (int g = 0; g < 16; ++g) st[b][g] = CARRY[(size_t)(32 * b + crow(g, hi)) * 256 + 32 * wid + r];
    } else {
#pragma unroll
        for (int b = 0; b < 4; ++b)
#pragma unroll
            for (int g = 0; g < 16; ++g) st[b][g] = 0.f;
    }
    bf16x8 vbN[4], kaN[4][4];
#pragma unroll
    for (int ks = 0; ks < 4; ++ks) { vbN[ks] = *(const bf16x8*)(VTG + ((size_t)(4 * s) * 1024 + h * 256 + 32 * wid + r) * 64 + 16 * ks + 8 * hi);
#pragma unroll
        for (int b = 0; b < 4; ++b) kaN[ks][b] = *(const bf16x8*)(KDT + ((size_t)(4 * s) * 512 + h * 128 + 32 * b + r) * 64 + 16 * ks + 8 * hi); }
#pragma unroll 1
    for (int cn = 0; cn < 4; ++cn) {
        const int n = 4 * s + cn;
        if (FINAL) {
            { LAS unsigned char* qd_ = q_s + qrow_ * 264 + 16 * qch_;
              *(LAS u32x2*)qd_ = (u32x2){qpre0[0], qpre0[1]}; *(LAS u32x2*)(qd_ + 8) = (u32x2){qpre0[2], qpre0[3]}; *(LAS u32x2*)(qd_ + 128) = (u32x2){qpre1[0], qpre1[1]}; *(LAS u32x2*)(qd_ + 136) = (u32x2){qpre1[2], qpre1[3]}; }
            if (cn < 3) { const bf16_t* qp_ = PROJ + (size_t)(64 * (n + 1) + qrow_) * NPROJ + C_GQ + h * 128 + 8 * qch_; qpre0 = *(const u32x4*)qp_; qpre1 = *(const u32x4*)(qp_ + 64); }
        }
#pragma unroll
        for (int b = 0; b < 4; ++b)
#pragma unroll
            for (int g4 = 0; g4 < 4; ++g4) { const f32x4 d = *(const f32x4*)(DEC + n * 512 + h * 128 + 32 * b + 8 * g4 + 4 * hi);
#pragma unroll
                for (int i = 0; i < 4; ++i) st[b][4 * g4 + i] *= d[i]; }
#pragma unroll
        for (int ks = 0; ks < 4; ++ks) {
#pragma unroll
            for (int b = 0; b < 4; ++b) st[b] = MFMA32(kaN[ks][b], vbN[ks], st[b]);
        }
        if (cn < 3) {
#pragma unroll
            for (int ks = 0; ks < 4; ++ks) { vbN[ks] = *(const bf16x8*)(VTG + ((size_t)(n + 1) * 1024 + h * 256 + 32 * wid + r) * 64 + 16 * ks + 8 * hi);
#pragma unroll
                for (int b = 0; b < 4; ++b) kaN[ks][b] = *(const bf16x8*)(KDT + ((size_t)(n + 1) * 512 + h * 128 + 32 * b + r) * 64 + 16 * ks + 8 * hi); }
        }
        if (FINAL) {
            f32x16 o[2];
#pragma unroll
            for (int tb = 0; tb < 2; ++tb)
#pragma unroll
                for (int g = 0; g < 16; ++g) o[tb][g] = 0.f;
            __syncthreads();
#pragma unroll
            for (int b = 0; b < 4; ++b)
#pragma unroll
                for (int s2 = 0; s2 < 2; ++s2) {
                    u32x4 sb = {pk2(st[b][8 * s2 + 0], st[b][8 * s2 + 1]), pk2(st[b][8 * s2 + 2], st[b][8 * s2 + 3]), pk2(st[b][8 * s2 + 4], st[b][8 * s2 + 5]), pk2(st[b][8 * s2 + 6], st[b][8 * s2 + 7])};
#pragma unroll
                    for (int tb = 0; tb < 2; ++tb) {
                        LAS const unsigned char* qp = q_s + (32 * tb + r) * 264 + 2 * (32 * b + 16 * s2 + 4 * hi);
                        const u32x2 q0 = *(LAS const u32x2*)qp, q1 = *(LAS const u32x2*)(qp + 16);
                        u32x4 qa = {q0[0], q0[1], q1[0], q1[1]};
                        o[tb] = MFMA32(__builtin_bit_cast(bf16x8, qa), __builtin_bit_cast(bf16x8, sb), o[tb]);
                    }
                }
            __syncthreads();
#pragma unroll
            for (int tb = 0; tb < 2; ++tb)
#pragma unroll
                for (int g = 0; g < 16; ++g) o_s[(32 * tb + crow(g, hi)) * 256 + 32 * wid + r] = o[tb][g] * 0.08838834764831845f;
            __syncthreads();
            bf16_t* OGLA = (bf16_t*)(p.ws + OFF_OGLA);
#pragma unroll
            for (int i = 0; i < 8; ++i) {
                const int c = 8 * wid + i; const size_t t = (size_t)64 * n + c;
                const f32x4 v = *(const f32x4*)(o_s + c * 256 + 4 * lane);
                float ss = wave_sum(v[0] * v[0] + v[1] * v[1] + v[2] * v[2] + v[3] * v[3]);
                const float rstd = rsqrtf(ss * (1.0f / 256.0f) + EPS);
                const f32x4 gn = *(const f32x4*)(p.gla_onorm_g + 4 * lane);
                const u32x2 gg = *(const u32x2*)(PROJ + t * NPROJ + C_GG + h * 256 + 4 * lane);
                const float y0 = v[0] * rstd * gn[0] * siluf_(bflo(gg[0])), y1 = v[1] * rstd * gn[1] * siluf_(bfhi(gg[0])), y2 = v[2] * rstd * gn[2] * siluf_(bflo(gg[1])), y3 = v[3] * rstd * gn[3] * siluf_(bfhi(gg[1]));
                *(unsigned*)((unsigned char*)OGLA + t * D_ + h * 256 + 4 * lane) = pk4_fp8(y0, y1, y2, y3);
            }
        }
    }
    if (!FINAL) { float* LOC = (float*)(p.ws + OFF_LOC) + sbase;
#pragma unroll
        for (int b = 0; b < 4; ++b)
#pragma unroll
            for (int g = 0; g < 16; ++g) LOC[(size_t)(32 * b + crow(g, hi)) * 256 + 32 * wid + r] = st[b][g];
    }
}
__device__ __forceinline__ void phase_g2(const P& p, int bid, int G) {
    const float* LOC = (const float*)(p.ws + OFF_LOC); float* CARRY = (float*)(p.ws + OFF_CARRY); const float* DEC = (const float*)(p.ws + OFF_DEC);
    for (int e = bid * NTHR + tid_(); e < 131072; e += G * NTHR) {
        const int h = e >> 15, dk = (e >> 8) & 127; float carry = 0.f;
        const float* d0 = DEC + h * 128 + dk;
#pragma unroll 1
        for (int s0 = 0; s0 < 64; s0 += 16) {
            float lv[16], pd[16];
#pragma unroll
            for (int i = 0; i < 16; ++i) { const float* d = d0 + (4 * (s0 + i)) * 512; lv[i] = LOC[(size_t)(s0 + i) * 131072 + e]; pd[i] = d[0] * d[512] * d[1024] * d[1536]; }
#pragma unroll
            for (int i = 0; i < 16; ++i) { CARRY[(size_t)(s0 + i) * 131072 + e] = carry; carry = lv[i] + pd[i] * carry; }
        }
    }
}

constexpr int ATT_STAGE = 32768;
typedef int i32x8a __attribute__((ext_vector_type(8)));
typedef int i32x4a __attribute__((ext_vector_type(4)));
typedef short s16x2a __attribute__((ext_vector_type(2)));
__device__ __forceinline__ int pk4_fp8_div(float a, float b, float c, float d, float scale) { s16x2a w = {0, 0}; w = __builtin_amdgcn_cvt_scalef32_pk_fp8_f32(w, a, b, scale, false); w = __builtin_amdgcn_cvt_scalef32_pk_fp8_f32(w, c, d, scale, true); return __builtin_bit_cast(int, w); }
__device__ __forceinline__ i32x8a cat16u(u32x4 lo, u32x4 hi) { return __builtin_shufflevector(__builtin_bit_cast(i32x4a, lo), __builtin_bit_cast(i32x4a, hi), 0, 1, 2, 3, 4, 5, 6, 7); }
template <int AV>
__device__ __forceinline__ void attn_unit(const P& p, int h, int qb, unsigned char* smem) {
    const int tid = tid_(), lane = tid & 63, r = lane & 31, hi = lane >> 5; const int wid = __builtin_amdgcn_readfirstlane(tid >> 6);
    const unsigned char* K8 = p.ws + OFF_K8 + h * 128; const unsigned char* V8T = p.ws + OFF_V8T + (size_t)h * 128 * T_;
    LAS unsigned char* lds = (LAS unsigned char*)smem;
    const int q0 = qb * 256 + wid * 32, qc = q0 >> 6, nt = 2 * qb + 2;
#define ATT_STAGE_TILE(kt, buf) do { const int t3_ = tid_(); const unsigned srow_ = (unsigned)(t3_ >> 3), sch_ = (unsigned)((t3_ & 7) ^ ((t3_ >> 4) & 7)); \
        _Pragma("unroll") for (int j_ = 0; j_ < 2; ++j_) { \
        __builtin_amdgcn_global_load_lds((const unsigned*)(K8 + ((size_t)(kt) * 128 + 64 * j_ + srow_) * D_ + 16 * sch_), (LAS unsigned*)(lds + (buf) * ATT_STAGE + (512 * j_ + 64 * wid) * 16), 16, 0, 0); \
        __builtin_amdgcn_global_load_lds((const unsigned*)(V8T + (size_t)(64 * j_ + srow_) * T_ + (size_t)(kt) * 128 + 16 * sch_), (LAS unsigned*)(lds + (buf) * ATT_STAGE + 16384 + (512 * j_ + 64 * wid) * 16), 16, 0, 0); } } while (0)
    const unsigned FX = (unsigned)r * 128u + ((unsigned)((2 * hi) ^ ((r >> 1) & 7)) << 4);
    ATT_STAGE_TILE(0, 0);
    LAS unsigned char* qbase = lds + 3 * ATT_STAGE + wid * 4096;
    { const unsigned char* qrow = p.ws + OFF_Q8 + (size_t)(q0 + r) * D_ + h * 128 + 32 * hi;
#pragma unroll
      for (int m = 0; m < 2; ++m) { *(LAS u32x4*)(qbase + (FX ^ (unsigned)(64 * m))) = *(const u32x4*)(qrow + 64 * m); *(LAS u32x4*)(qbase + (FX ^ (unsigned)(64 * m + 16))) = *(const u32x4*)(qrow + 64 * m + 16); } }
    float noff;
    { int z = 0; asm volatile("" : "+v"(z)); float gq = 0.f, gk = 0.f;
      for (int i = 0; i < 64; ++i) { gq = fmaxf(gq, fabsf(p.qn_g[i + z])); gk = fmaxf(gk, fabsf(p.kn_g[i + z])); }
      noff = exp2f(ceilf(8.0f * 1.4426950408889634f * gq * gk) - 8.0f); }
    f32x16 O[2][4]; f32x2v la0 = {0.f, 0.f}, la1 = {0.f, 0.f};
#pragma unroll
    for (int m = 0; m < 2; ++m)
#pragma unroll
        for (int d = 0; d < 4; ++d)
#pragma unroll
            for (int g = 0; g < 16; ++g) O[m][d][g] = 0.f;
    i32x8a p8[2];
#pragma unroll
    for (int m = 0; m < 2; ++m)
#pragma unroll
        for (int g = 0; g < 8; ++g) p8[m][g] = 0;
    const f32x16 zero16 = {0.f, 0.f, 0.f, 0.f, 0.f, 0.f, 0.f, 0.f, 0.f, 0.f, 0.f, 0.f, 0.f, 0.f, 0.f, 0.f};
#define ATT_KF(dst, kb_, m_) dst = cat16u(*(LAS const u32x4*)((kb_) + (FX ^ (unsigned)(64 * (m_)))), *(LAS const u32x4*)((kb_) + (FX ^ (unsigned)(64 * (m_) + 16))))
#define ATT_VF(dst, v0_, v1_, d_) dst = cat16u(*(LAS const u32x4*)((v0_) + 4096 * (d_)), *(LAS const u32x4*)((v1_) + 4096 * (d_)))
#define ATT_EXPG(SC, PM, PO, j_, SCL) do { if (AV == 1) { p8[1 - (PM)][(PO) + (j_)] = (int)(__float_as_uint(SC[4 * (j_)]) ^ __float_as_uint(SC[4 * (j_) + 1]) ^ __float_as_uint(SC[4 * (j_) + 2]) ^ __float_as_uint(SC[4 * (j_) + 3])); break; } \
        _Pragma("unroll") for (int g_ = 4 * (j_); g_ < 4 * (j_) + 4; ++g_) SC[g_] = __builtin_amdgcn_exp2f(SC[g_]); \
        int w_; asm("v_cvt_scalef32_pk_fp8_f32 %0, %1, %2, %3" : "=v"(w_) : "v"(SC[4 * (j_)]), "v"(SC[4 * (j_) + 1]), "v"(SCL)); \
        asm("v_cvt_scalef32_pk_fp8_f32 %0, %1, %2, %3 op_sel:[0,0,0,1]" : "+v"(w_) : "v"(SC[4 * (j_) + 2]), "v"(SC[4 * (j_) + 3]), "v"(SCL)); \
        p8[1 - (PM)][(PO) + (j_)] = w_; } while (0)
#define ATT_STEP(SC, SN, DO_S, PM, V0, V1, PD, PO, LA, NDO, NKB, NM, NQ, MV, SCL) do { \
        i32x8a va_, vb_; \
        ATT_VF(va_, V0, V1, PD); ATT_VF(vb_, V0, V1, (PD) + 1); \
        __builtin_amdgcn_sched_barrier(0); \
        ATT_EXPG(SC, PM, PO, 0, SCL); \
        if (DO_S) { SN = __builtin_amdgcn_mfma_scale_f32_32x32x64_f8f6f4(kfN, qN, zero16, 0, 0, 0, 0x7F7F7F7F, 0, 0x7C7C7C7C); asm volatile("" : "+v"(SN)); }     \
        __builtin_amdgcn_sched_group_barrier(0x400, 4, 0); __builtin_amdgcn_sched_group_barrier(0x008, 1, 0); \
        __builtin_amdgcn_sched_barrier(0); \
        ATT_EXPG(SC, PM, PO, 1, SCL); \
        O[PM][PD] = __builtin_amdgcn_mfma_scale_f32_32x32x64_f8f6f4(p8[PM], va_, O[PM][PD], 0, 0, 0, 0x7F7F7F7F, 0, 0x7F7F7F7F); \
        __builtin_amdgcn_sched_group_barrier(0x400, 4, 0); __builtin_amdgcn_sched_group_barrier(0x008, 1, 0); \
        __builtin_amdgcn_sched_barrier(0); \
        ATT_EXPG(SC, PM, PO, 2, SCL); \
        O[PM][(PD) + 1] = __builtin_amdgcn_mfma_scale_f32_32x32x64_f8f6f4(p8[PM], vb_, O[PM][(PD) + 1], 0, 0, 0, 0x7F7F7F7F, 0, 0x7F7F7F7F); \
        if (NDO) ATT_KF(kfN, NKB, NM); if (NQ) ATT_KF(qN, qbase, NM); \
        __builtin_amdgcn_sched_group_barrier(0x400, 4, 0); __builtin_amdgcn_sched_group_barrier(0x008, 1, 0); \
        __builtin_amdgcn_sched_barrier(0); \
        ATT_EXPG(SC, PM, PO, 3, SCL); \
        if (AV != 1) { _Pragma("unroll") for (int g_ = 0; g_ < 8; ++g_) LA = (f32x2v){SC[2 * g_], SC[2 * g_ + 1]} * (f32x2v){MV, MV} + LA; } \
        __builtin_amdgcn_sched_barrier(0); } while (0)
#define ATT_FLUSH(V0, V1) do { _Pragma("unroll") for (int d_ = 0; d_ < 4; ++d_) { i32x8a vf_; ATT_VF(vf_, V0, V1, d_); \
        O[1][d_] = __builtin_amdgcn_mfma_scale_f32_32x32x64_f8f6f4(p8[1], vf_, O[1][d_], 0, 0, 0, 0x7F7F7F7F, 0, 0x7F7F7F7F); } \
        __builtin_amdgcn_sched_barrier(0); } while (0)
    LAS const unsigned char* pv0 = lds + 16384 + FX; LAS const unsigned char* pv1 = lds + 16384 + (FX ^ 16u);
    asm volatile("s_waitcnt vmcnt(0)" ::: "memory"); __syncthreads();
    if (wid >= 4) __builtin_amdgcn_s_setprio(1);
    int st = 0, st1 = 1;
#pragma unroll 1
    for (int kt = 0; kt < nt; ++kt) {
        if (kt + 1 < nt) ATT_STAGE_TILE(kt + 1, st1);
        const int nch = qc - 2 * kt + 1;
        LAS const unsigned char* sb = lds + st * ATT_STAGE;
        {
            const float mv0 = nch >= 1 ? 1.f : 0.f, mv1 = nch >= 2 ? 1.f : 0.f, sc0 = nch >= 1 ? noff : 0x1p120f, sc1 = nch >= 2 ? noff : 0x1p120f;
            f32x16 SA, SB; i32x8a kfN, qN;
            ATT_KF(kfN, sb, 0); ATT_KF(qN, qbase, 0);
            SA = __builtin_amdgcn_mfma_scale_f32_32x32x64_f8f6f4(kfN, qN, zero16, 0, 0, 0, 0x7F7F7F7F, 0, 0x7C7C7C7C);
            __builtin_amdgcn_sched_barrier(0);
            ATT_KF(kfN, sb + 4096, 0);
            __builtin_amdgcn_sched_barrier(0);
            LAS const unsigned char* c0 = sb + 16384 + FX; LAS const unsigned char* c1 = sb + 16384 + (FX ^ 16u);
            ATT_STEP(SA, SB, true, 1, pv0, pv1, 0, 0, la0,  true, sb, 1, true, mv0, sc0);
            ATT_STEP(SB, SA, true, 1, pv0, pv1, 2, 4, la0,  true, sb + 4096, 1, false, mv0, sc0);
            ATT_STEP(SA, SB, true, 0, c0, c1, 0, 0, la1,    true, sb + 8192, 0, true, mv0, sc0);
            ATT_STEP(SB, SA, true, 0, c0, c1, 2, 4, la1,    true, sb + 12288, 0, false, mv0, sc0);
            pv0 = sb + 16384 + (FX ^ 64u); pv1 = sb + 16384 + (FX ^ 80u);
            ATT_STEP(SA, SB, true, 1, c0, c1, 0, 0, la0,    true, sb + 8192, 1, true, mv1, sc1);
            ATT_STEP(SB, SA, true, 1, c0, c1, 2, 4, la0,    true, sb + 12288, 1, false, mv1, sc1);
            ATT_STEP(SA, SB, true, 0, pv0, pv1, 0, 0, la1,  false, sb, 0, false, mv1, sc1);
            ATT_STEP(SB, SA, false, 0, pv0, pv1, 2, 4, la1, false, sb, 0, false, mv1, sc1);
        }
        asm volatile("s_waitcnt vmcnt(0)" ::: "memory"); __syncthreads();
        st = st1; st1 = st1 == 2 ? 0 : st1 + 1;
    }
    ATT_FLUSH(pv0, pv1);
    __syncthreads();
    __builtin_amdgcn_s_setprio(0);
    float l0 = la0[0] + la0[1], l1 = la1[0] + la1[1];
#undef ATT_KF
#undef ATT_VF
#undef ATT_EXPG
#undef ATT_STEP
#undef ATT_FLUSH
#undef ATT_STAGE_TILE
    {
        const int tid2 = tid_(), lane2 = tid2 & 63, r2 = lane2 & 31, hi2 = lane2 >> 5; const int wid2 = __builtin_amdgcn_readfirstlane(tid2 >> 6);
        const int q02 = qb * 256 + wid2 * 32;
        int z = 0; asm volatile("" : "+v"(z));
        float la = 0.f, lb = 0.f;
        for (int i = 0; i < 64; ++i) { la += p.lq1[i + z] * p.lk1[i + z]; lb += p.lq2[i + z] * p.lk2[i + z]; }
        const float lam = __expf(la) - __expf(lb) + 0.2f;
        l0 += __uint_as_float(__builtin_amdgcn_ds_bpermute((lane2 ^ 32) << 2, __float_as_uint(l0)));
        l1 += __uint_as_float(__builtin_amdgcn_ds_bpermute((lane2 ^ 32) << 2, __float_as_uint(l1)));
        float gq2 = 0.f, gk2 = 0.f;
        for (int i = 0; i < 64; ++i) { gq2 = fmaxf(gq2, fabsf(p.qn_g[i + z])); gk2 = fmaxf(gk2, fabsf(p.kn_g[i + z])); }
        const float unsc = exp2f(ceilf(8.0f * 1.4426950408889634f * gq2 * gk2) - 8.0f);
        const float i0 = unsc / l0, i1 = unsc * lam / l1;
        bf16_t* ODIFF = (bf16_t*)(p.ws + OFF_ODIFF);
        float sgv[4];
#pragma unroll
        for (int d = 0; d < 4; ++d) sgv[d] = p.subln_g[32 * d + r2 + z] * 0.8f;
#pragma unroll
        for (int g = 0; g < 16; ++g) {
            const int row = crow(g, hi2);
            const float a0 = __uint_as_float(__builtin_amdgcn_ds_bpermute(row << 2, __float_as_uint(i0))), a1 = __uint_as_float(__builtin_amdgcn_ds_bpermute(row << 2, __float_as_uint(i1)));
            float o[4], ss = 0.f;
#pragma unroll
            for (int d = 0; d < 4; ++d) { o[d] = O[0][d][g] * a0 - O[1][d][g] * a1; ss += o[d] * o[d]; }
#pragma unroll
            for (int of = 16; of >= 1; of >>= 1) ss += __uint_as_float(__builtin_amdgcn_ds_bpermute((lane2 ^ of) << 2, __float_as_uint(ss)));
            const float rstd = rsqrtf(ss * (1.0f / 128.0f) + EPS);
#pragma unroll
            for (int d = 0; d < 4; ++d) ((unsigned char*)ODIFF)[(size_t)(q02 + row) * D_ + h * 128 + 32 * d + r2] = (unsigned char)pk4_fp8(o[d] * rstd * sgv[d], 0.f, 0.f, 0.f);
        }
    }
}

template <int CTRL> __device__ __forceinline__ float dppf_(float x) { return __int_as_float(__builtin_amdgcn_update_dpp(0, __float_as_int(x), CTRL, 0xF, 0xF, false)); }
template <bool PROBE = false>
__device__ __forceinline__ void phase_route(const P& p, int bid, int G) {
    const int tid = tid_(), wid = tid >> 6, lane = tid & 63;
    const float* LOGITS = (const float*)(p.ws + OFF_LOGITS); int* cnt = (int*)(p.ws + OFF_CTL) + (PROBE ? 8192 : 0);
    int* EIDX = (int*)(p.ws + (PROBE ? OFF_PROJ + 40 * MiB : OFF_EIDX)); int* POSI = (int*)(p.ws + (PROBE ? OFF_PROJ + 41 * MiB : OFF_POSI)); int* TOKL = (int*)(p.ws + (PROBE ? OFF_PROJ : OFF_TOKL)); float* WL = (float*)(p.ws + (PROBE ? OFF_PROJ + 16 * MiB : OFF_WL));
    const f32x4 bias = *(const f32x4*)(p.router_bias + 4 * lane);
    int pt = -1, pE = 0, ppos = 0; float pw = 0.f;
    const int tstart = bid * 8 + wid, tstep = G * 8;
    f32x4 lgn = {0.f, 0.f, 0.f, 0.f};
    if (tstart < T_) lgn = *(const f32x4*)(LOGITS + (size_t)tstart * 256 + 4 * lane);
#pragma unroll 1
    for (int t = tstart; t < T_; t += tstep) {
        const f32x4 lg = lgn;
        if (t + tstep < T_) lgn = *(const f32x4*)(LOGITS + (size_t)(t + tstep) * 256 + 4 * lane);
        float sc[4], bv[4];
#pragma unroll
        for (int i = 0; i < 4; ++i) { sc[i] = sigmoidf_(lg[i]); bv[i] = sc[i] + bias[i]; }
        float m1 = fmaxf(bv[0], bv[1]), m2 = fminf(bv[0], bv[1]);
#pragma unroll
        for (int i = 2; i < 4; ++i) { const float a = bv[i]; m2 = fmaxf(m2, fminf(m1, a)); m1 = fmaxf(m1, a); }
        { float b1 = dppf_<0xB1>(m1), b2 = dppf_<0xB1>(m2); m2 = fmaxf(fminf(m1, b1), fmaxf(m2, b2)); m1 = fmaxf(m1, b1);
          b1 = dppf_<0x4E>(m1); b2 = dppf_<0x4E>(m2); m2 = fmaxf(fminf(m1, b1), fmaxf(m2, b2)); m1 = fmaxf(m1, b1);
          b1 = dppf_<0x141>(m1); b2 = dppf_<0x141>(m2); m2 = fmaxf(fminf(m1, b1), fmaxf(m2, b2)); m1 = fmaxf(m1, b1); }
        const float gs = m1 + m2; const int grp = lane >> 3; int rank = 0;
#pragma unroll
        for (int g2 = 0; g2 < 8; ++g2) { const float og = __int_as_float(__builtin_amdgcn_readlane(__float_as_int(gs), 8 * g2)); rank += (og > gs || (og == gs && g2 < grp)) ? 1 : 0; }
        const bool sel = rank < 4;
        float v[4];
#pragma unroll
        for (int i = 0; i < 4; ++i) v[i] = sel ? bv[i] : -INFINITY;
        int myE = 0; float myS = 0.f; float ssum = 0.f;
#pragma unroll
        for (int k = 0; k < 8; ++k) {
            float lm = v[0]; int li = 0;
#pragma unroll
            for (int i = 1; i < 4; ++i) if (v[i] > lm) { lm = v[i]; li = i; }
            float r = fmaxf(lm, dppf_<0xB1>(lm)); r = fmaxf(r, dppf_<0x4E>(r)); r = fmaxf(r, dppf_<0x141>(r)); r = fmaxf(r, dppf_<0x140>(r));
            const float r0 = __int_as_float(__builtin_amdgcn_readlane(__float_as_int(r), 0)), r1 = __int_as_float(__builtin_amdgcn_readlane(__float_as_int(r), 16));
            const float r2 = __int_as_float(__builtin_amdgcn_readlane(__float_as_int(r), 32)), r3 = __int_as_float(__builtin_amdgcn_readlane(__float_as_int(r), 48));
            const float gm = fmaxf(fmaxf(r0, r1), fmaxf(r2, r3));
            const unsigned long long bal = __builtin_amdgcn_ballot_w64(lm == gm);
            const int owner = (int)__builtin_ctzll(bal);
            const float ls = li == 0 ? sc[0] : (li == 1 ? sc[1] : (li == 2 ? sc[2] : sc[3]));
            const float sv = __int_as_float(__builtin_amdgcn_readlane(__float_as_int(ls), owner));
            const int wi = __builtin_amdgcn_readlane(li, owner);
            const int be = 4 * owner + wi;
            if (lane == owner) {
#pragma unroll
                for (int i = 0; i < 4; ++i) if (i == wi) v[i] = -INFINITY;
            }
            ssum += sv;
            if (lane == k) { myE = be; myS = sv; }
        }
        if (lane < 8 && pt >= 0) { const size_t li_ = (size_t)pE * T_ + (size_t)((pt >> 3) & 7) * (T_ / 8) + ppos; TOKL[li_] = pt; WL[li_] = pw; EIDX[pt * 8 + lane] = pE; POSI[pt * 8 + lane] = ppos; }
        pt = t; pE = myE; pw = myS / ssum * 2.5f;
        if (lane < 8) ppos = atomicAdd(cnt + myE * 8 + ((t >> 3) & 7), 1);
    }
    if (lane < 8 && pt >= 0) { const size_t li_ = (size_t)pE * T_ + (size_t)((pt >> 3) & 7) * (T_ / 8) + ppos; TOKL[li_] = pt; WL[li_] = pw; EIDX[pt * 8 + lane] = pE; POSI[pt * 8 + lane] = ppos; }
}

#define XB_TMO      128
#define XB_XCNT(j)  (256  + 64 * (j))
#define XB_XSUB(j)  (1280 + 64 * (j))
#define XB_XGEN(j)  (2304 + 64 * (j))
#define XB_TOP      3328
#define XB_TOPGEN   3392
#define XCD_BAR_WORDS 3456
#define XB_SPIN_CAP (1u << 18)

__device__ __forceinline__ unsigned xb_ld(unsigned* p)              { return __hip_atomic_load(p, __ATOMIC_RELAXED, __HIP_MEMORY_SCOPE_AGENT); }
__device__ __forceinline__ unsigned xb_add(unsigned* p, unsigned v) { return __hip_atomic_fetch_add(p, v, __ATOMIC_RELAXED, __HIP_MEMORY_SCOPE_AGENT); }
__device__ __forceinline__ unsigned xb_xcc_id() { return (unsigned)__builtin_amdgcn_s_getreg((3 << 11) | 20) & 0xFu; }
#define XB_SPIN(cond, bar) do { unsigned _sp = 0; while (cond) { __builtin_amdgcn_s_sleep(1); \
    if ((++_sp & 255u) == 0u) { if (xb_ld(&(bar)[XB_TMO])) break; if (_sp > XB_SPIN_CAP) { atomicAdd(&(bar)[XB_TMO], 1u); break; } } } } while (0)

struct XcdBarrier {
    unsigned* bar; unsigned x;
    volatile LAS unsigned* st;
};

__device__ __forceinline__ XcdBarrier xcd_barrier_post(unsigned* bar, volatile LAS unsigned* st) {
    XcdBarrier b; b.bar = bar; b.x = xb_xcc_id(); b.st = st;
    if (threadIdx.x == 0) (void)xb_add(&bar[XB_XCNT(b.x)], 1u);
    return b;
}
__device__ __forceinline__ void xcd_barrier_complete(unsigned* bar, unsigned x, unsigned& nloc, unsigned& nx) {
    const unsigned G = gridDim.x * gridDim.y * gridDim.z;
    unsigned sum, cnt, mine, sp = 0u;
    for (;;) {
        sum = 0u; cnt = 0u; mine = 0u;
#pragma unroll
        for (unsigned j = 0; j < 16; ++j) { const unsigned c = xb_ld(&bar[XB_XCNT(j)]); sum += c; cnt += (c > 0u) ? 1u : 0u; mine = (j == x) ? c : mine; }
        if (sum == G) break;
        __builtin_amdgcn_s_sleep(1);
        if ((++sp & 255u) == 0u) { if (xb_ld(&bar[XB_TMO])) break; if (sp > XB_SPIN_CAP) { atomicAdd(&bar[XB_TMO], 1u); break; } }
    }
    nloc = mine > 0u ? mine : 1u; nx = cnt > 0u ? cnt : 1u;
}

__device__ __forceinline__ void xcd_barrier(const XcdBarrier& b) {
    asm volatile("s_waitcnt vmcnt(0)" ::: "memory");
    __syncthreads();
    if (threadIdx.x == 0) {
        unsigned* bar = b.bar;
        __builtin_amdgcn_s_waitcnt(0);
        unsigned nloc = b.st[0], nx = b.st[1];
        if (nloc == 0u) { xcd_barrier_complete(bar, b.x, nloc, nx); b.st[0] = nloc; b.st[1] = nx; }
        const unsigned old = xb_add(&bar[XB_XSUB(b.x)], 1u);
        const unsigned gen = old / nloc;
        if (old + 1u == (gen + 1u) * nloc) {
            __builtin_amdgcn_fence(__ATOMIC_RELEASE, "agent");
            asm volatile("s_waitcnt vmcnt(0)" ::: "memory");
            const unsigned og = xb_add(&bar[XB_TOP], 1u);
            const unsigned tg = og / nx;
            if (og + 1u == (tg + 1u) * nx) xb_add(&bar[XB_TOPGEN], 1u);
            else XB_SPIN(xb_ld(&bar[XB_TOPGEN]) == tg, bar);
            __builtin_amdgcn_fence(__ATOMIC_ACQUIRE, "agent");
            xb_add(&bar[XB_XGEN(b.x)], 1u);
            asm volatile("s_waitcnt vmcnt(0)" ::: "memory");
        } else {
            XB_SPIN(xb_ld(&bar[XB_XGEN(b.x)]) == gen, bar);
            __builtin_amdgcn_fence(__ATOMIC_ACQUIRE, "agent");
            asm volatile("s_waitcnt vmcnt(0)" ::: "memory");
        }
    }
    __syncthreads();
}

constexpr size_t OFF_BAR = 16 << 10;
struct RowGather { const int* tokl; int pos0, cnt; __device__ __forceinline__ unsigned operator()(int r) const { int pos = pos0 + r; pos = pos < cnt ? pos : cnt - 1; return (unsigned)tokl[pos] * 1024u; } };
struct RowSlots { int base, pos0, cnt; __device__ __forceinline__ unsigned operator()(int r) const { int pos = pos0 + r; pos = pos < cnt ? pos : cnt - 1; return (unsigned)(base + pos) * 256u; } };

__device__ __forceinline__ void ph_norm1(const P& p, int bid, int G) { const float* mod = (const float*)(p.ws + OFF_MOD); phase_norm(p.x, p.norm1_g, mod + 1024, mod, (bf16_t*)(p.ws + OFF_H), p.ws + OFF_H2F8, bid, G); }
__device__ __forceinline__ void ph_inproj(const P& p, unsigned char* smem, int bid, int G) {
    EpiStoreBf16 E{(bf16_t*)(p.ws + OFF_PROJ), NPROJ};
    pg8::Gemm g{(const bf16_t*)(p.ws + OFF_H2F8), (const bf16_t*)(p.ws + OFF_WINT), T_, NPROJ, 512}; pg8::StaticOrder S; S.init(T_, NPROJ, G, bid);
    pg8::gemm_phase<EpiStoreBf16, pg8::StaticOrder, false, true, true>((PG8_LAS unsigned char*)smem, g, S, E);
}
__device__ __forceinline__ void ph_prep(const P& p, unsigned char* smem, int bid, int G) {
#pragma unroll 1
    for (int n = bid; n < 256; n += G) prep_chunk(p, n, smem);
}
template <bool FINAL> __device__ __forceinline__ void ph_gla(const P& p, unsigned char* smem, int bid, int G) {
#pragma unroll 1
    for (int u = bid; u < 256; u += G) gla_unit<FINAL>(p, u >> 2, u & 3, smem);
}
template <int AV>
__device__ __forceinline__ void ph_att(const P& p, unsigned char* smem, int bid, int G) {
#pragma unroll 1
    for (int uu = bid * 2; uu < 512; uu += (uu & 1) ? 2 * G - 1 : 1) { const int u = uu >> 1, h = u & 7, j = u >> 3; attn_unit<AV>(p, h, (uu & 1) ? 63 - j : j, smem); }
}
__device__ __forceinline__ void ph_b1(const P& p, unsigned char* smem, int bid, int G) {
    const bf16_t* PROJ = (const bf16_t*)(p.ws + OFF_PROJ);
    bf16_t* M1 = (bf16_t*)(p.ws + OFF_H);
    EpiB1a Ea{M1, PROJ}; EpiB1b Eb{M1, PROJ, (bf16_t*)(p.ws + OFF_MERGED)};
    pg8::StaticOrder S; S.init(T_, D_, G, bid);
    { pg8::Gemm g{(const bf16_t*)(p.ws + OFF_OGLA), (const bf16_t*)(p.ws + OFF_WBG), T_, D_, 512};
      pg8::gemm_phase<EpiB1a, pg8::StaticOrder, true, true, true>((PG8_LAS unsigned char*)smem, g, S, Ea); }
    __threadfence_block();
    { pg8::Gemm g{(const bf16_t*)(p.ws + OFF_ODIFF), (const bf16_t*)(p.ws + OFF_WBD), T_, D_, 512};
      pg8::gemm_phase<EpiB1b, pg8::StaticOrder, true, true, true>((PG8_LAS unsigned char*)smem, g, S, Eb); }
}
__device__ __forceinline__ void ph_b2(const P& p, unsigned char* smem, int bid, int G) {
    const float* mod = (const float*)(p.ws + OFF_MOD); EpiB2 E{p.x, mod + 2048, p.out};
    pg8::Gemm g{(const bf16_t*)(p.ws + OFF_MERGED), (const bf16_t*)(p.ws + OFF_WO), T_, D_, 512}; pg8::StaticOrder S; S.init(T_, D_, G, bid);
    pg8::gemm_phase<EpiB2, pg8::StaticOrder, true, true, true>((PG8_LAS unsigned char*)smem, g, S, E);
}
__device__ __forceinline__ void ph_norm2(const P& p, int bid, int G) { const float* mod = (const float*)(p.ws + OFF_MOD); phase_norm(p.out, p.norm2_g, mod + 4096, mod + 3072, (bf16_t*)(p.ws + OFF_H), p.ws + OFF_H2F8, bid, G); }
__device__ __forceinline__ void ph_f1(const P& p, unsigned char* smem, int bid, int G) {
    EpiF1 E{(float*)(p.ws + OFF_LOGITS), (bf16_t*)(p.ws + OFF_HS)};
    pg8::Gemm g{(const bf16_t*)(p.ws + OFF_H), (const bf16_t*)(p.ws + OFF_WF), T_, 768, 1024}; pg8::StaticOrder S; S.init(T_, 768, G, bid);
    pg8::gemm_phase<EpiF1, pg8::StaticOrder, true, true>((PG8_LAS unsigned char*)smem, g, S, E);
}
__device__ __forceinline__ void ph_route(const P& p, unsigned char* smem, int bid, int G) {
#ifndef RTP
#define RTP 0
#endif
    if (RTP) { phase_route<true>(p, bid, G); __syncthreads(); }
    phase_route<false>(p, bid, G);
    EpiStoreBf16 E{(bf16_t*)(p.ws + OFF_SD), D_};
    pg8::Gemm g{(const bf16_t*)(p.ws + OFF_HS), (const bf16_t*)(p.ws + OFF_WSD), T_, D_, 256}; pg8::StaticOrder S; S.init(T_, D_, G, bid);
#ifndef SDP
#define SDP 0
#endif
    pg8::gemm_phase<EpiStoreBf16, pg8::StaticOrder, true, true>((PG8_LAS unsigned char*)smem, g, S, E);
    if (SDP) { __syncthreads(); pg8::gemm_phase<EpiStoreBf16, pg8::StaticOrder, true, true>((PG8_LAS unsigned char*)smem, g, S, E); }
}
typedef short s16x4 __attribute__((ext_vector_type(4)));
__device__ __forceinline__ s16x4 ds_tr16(LAS const unsigned char* pp) { return __builtin_bit_cast(s16x4, __builtin_amdgcn_ds_read_tr16_b64_v4i16((LAS s16x4*)pp)); }
__device__ __forceinline__ void glds16_asm(const void* gsrc, unsigned lds_dst) { unsigned keep;
    asm volatile("s_mov_b32 %0, m0\n\ts_mov_b32 m0, %2\n\ts_nop 0\n\tglobal_load_lds_dwordx4 %1, off\n\ts_mov_b32 m0, %0" : "=&s"(keep) : "v"(gsrc), "s"(lds_dst) : "memory"); }
#ifndef MOE_NSL
#define MOE_NSL 2
#endif
constexpr int MOE_RING = 32768, MOE_BT = 3 * MOE_RING;
#ifndef XV
#define XV 0
#endif
__device__ __forceinline__ int list_idx(const int* so8, int r) { int sub = 0, off = 0; LAS const int* q8 = (LAS const int*)so8;
#pragma unroll
    for (int q = 1; q < 8; ++q) { const int o = q8[q]; if (r >= o) { sub = q; off = o; } }
    return sub * (T_ / 8) + (r - off); }
template <int MODE, int NA, int XVV = 0>
__device__ __forceinline__ void moe_pass(const P& p, unsigned char* smem, int e, int s, int cnt, int cstart, int row0, const int* so8) {
    constexpr int K = MODE == 0 ? 1024 : 256, NK = K / 64, BLD = MODE == 0 ? 256 : 1024;
    constexpr int NSL = MODE == 1 ? MOE_NSL : 1, NKT = NK * NSL;
    const int tid = tid_(), lane = tid & 63, fr = lane & 15, fq = lane >> 4; const int wid = __builtin_amdgcn_readfirstlane(tid >> 6);
    LAS unsigned char* lds = (LAS unsigned char*)smem; const unsigned lds0 = (unsigned)(uintptr_t)smem;
    const float* gsrc;
    { const int dk = tid >> 5, c4 = tid & 31;
      if (MODE == 0) gsrc = (c4 < 16 ? p.w_eg : p.w_eu) + (size_t)e * 1024 * 256 + (size_t)dk * 256 + 64 * s + 4 * (c4 & 15);
      else gsrc = p.w_ed + (size_t)e * 256 * 1024 + (size_t)dk * 1024 + 128 * (NSL * s) + 4 * c4; }
    constexpr int BLDX = XVV == 3 ? 0 : BLD; if (XVV == 3) gsrc = p.w_eg + 4 * (tid & 31);
    const int kr = tid >> 3, seg = tid & 7;
    const unsigned roff = (unsigned)kr * 512u + (unsigned)seg * 64u;
    unsigned woff[4];
    { const unsigned fk = (unsigned)((kr & 3) | (((kr >> 3) & 1) << 2)); const int gi = seg >> 1, hh = seg & 1;
#pragma unroll
      for (int q4 = 0; q4 < 4; ++q4) woff[q4] = (unsigned)MOE_BT + (unsigned)kr * 256u + ((((unsigned)(2 * gi + (q4 & 1))) ^ fk) << 5) + 8u * (unsigned)(2 * hh + (q4 >> 1)); }
    const int G4 = lane >> 4, q = (lane & 15) >> 2, pp = lane & 3;
    const unsigned LX = (unsigned)MOE_BT + (unsigned)(8 * G4 + q) * 256u + 8u * (unsigned)pp + ((unsigned)(q | ((G4 & 1) << 2)) << 5);
    const unsigned char* A = MODE == 0 ? (const unsigned char*)(p.ws + OFF_H2F8) : (const unsigned char*)(p.ws + OFF_HE);
    unsigned aoff[4];
    { const int* tokl = (const int*)(p.ws + OFF_TOKL) + (size_t)e * T_;
#pragma unroll
      for (int j = 0; j < 4; ++j) { int pos = row0 + 16 * (wid + 8 * j) + fr; pos = pos < cnt ? pos : cnt - 1;
          aoff[j] = MODE == 0 ? (unsigned)tokl[list_idx(so8, pos)] * 1024u + 8u * fq : (unsigned)(cstart + pos) * 256u + 8u * fq; } }
    constexpr int NA1 = NA > 0 ? NA : 1;
    f32x4 acc[NA1][8];
#pragma unroll
    for (int j = 0; j < NA1; ++j)
#pragma unroll
        for (int n = 0; n < 8; ++n) acc[j][n] = (f32x4){0.f, 0.f, 0.f, 0.f};
    u32x2 A0[NA1], A1[NA1];
#define MOE_DMA(t, slot) do { _Pragma("unroll") for (int j_ = 0; j_ < 4; ++j_) \
        glds16_asm(gsrc + (MODE == 1 ? (size_t)((t) >> 2) * 128 + ((size_t)((t) & 3) * 64 + 16 * j_) * BLDX : ((size_t)(t) * 64 + 16 * j_) * BLDX), (unsigned)__builtin_amdgcn_readfirstlane(lds0 + (unsigned)(slot) * MOE_RING + (512 * j_ + 64 * wid) * 16)); } while (0)
#define MOE_CONVERT(slot, bo) do { f32x4 br_[4]; _Pragma("unroll") for (int q4_ = 0; q4_ < 4; ++q4_) br_[q4_] = *(LAS const f32x4*)(lds + (slot) * MOE_RING + roff + 16 * q4_); \
        _Pragma("unroll") for (int q4_ = 0; q4_ < 4; ++q4_) { const u32x2 w_ = {pk2(br_[q4_][0], br_[q4_][1]), pk2(br_[q4_][2], br_[q4_][3])}; *(LAS u32x2*)(lds + (bo) + woff[q4_]) = w_; } } while (0)
#define MOE_LOADA0(AX, t, kk) do { if (NA > 0) { _Pragma("unroll") for (int j_ = 0; j_ < NA1; ++j_) { const unsigned vo_ = aoff[j_] + (unsigned)(MODE == 1 ? ((t) & 3) : (t)) * 64u; \
        asm volatile("s_nop 4\n\tglobal_load_dwordx2 %0, %1, %2 offset:%3" : "=v"(AX[j_]) : "v"(vo_), "s"(A), "i"(32 * (kk)) : "memory"); } } } while (0)
#define MOE_LOADA(AX, t, kk) do { if (NA > 0) { _Pragma("unroll") for (int j_ = 0; j_ < NA1; ++j_) { const unsigned vo_ = aoff[j_] + (unsigned)(MODE == 1 ? ((t) & 3) : (t)) * 64u; \
        asm volatile("s_nop 4\n\tglobal_load_dwordx2 %0, %1, %2 offset:%3" : "+v"(AX[j_]) : "v"(vo_), "s"(A), "i"(32 * (kk)) : "memory"); } } } while (0)
#define MOE_WAITA(AX, n) do { if (NA == 4) asm volatile("s_waitcnt vmcnt(%4)" : "+v"(AX[0]), "+v"(AX[NA1 > 1 ? 1 : 0]), "+v"(AX[NA1 > 2 ? 2 : 0]), "+v"(AX[NA1 > 3 ? 3 : 0]) : "i"(n) : "memory"); \
        else if (NA == 3) asm volatile("s_waitcnt vmcnt(%3)" : "+v"(AX[0]), "+v"(AX[NA1 > 1 ? 1 : 0]), "+v"(AX[NA1 > 2 ? 2 : 0]) : "i"(n) : "memory"); \
        else if (NA == 2) asm volatile("s_waitcnt vmcnt(%2)" : "+v"(AX[0]), "+v"(AX[NA1 > 1 ? 1 : 0]) : "i"(n) : "memory"); \
        else if (NA == 1) asm volatile("s_waitcnt vmcnt(%1)" : "+v"(AX[0]) : "i"(n) : "memory"); } while (0)
#define MOE_COMPUTE(AX, bo, kk) do { if (NA > 0) { bf16x8 aw_[NA1]; _Pragma("unroll") for (int j_ = 0; j_ < NA1; ++j_) aw_[j_] = fp8x8_to_bf16x8(AX[j_]); _Pragma("unroll") for (int n_ = 0; n_ < 8; ++n_) { \
        LAS const unsigned char* bp_ = lds + (bo) + (LX ^ (unsigned)(n_ << 5)) + (kk) * 8192; \
        const s16x4 t0_ = ds_tr16(bp_), t1_ = ds_tr16(bp_ + 1024); \
        const bf16x8 bf_ = {t0_[0], t0_[1], t0_[2], t0_[3], t1_[0], t1_[1], t1_[2], t1_[3]}; \
        _Pragma("unroll") for (int j_ = 0; j_ < NA1; ++j_) acc[j_][n_] = MFMA16(bf_, aw_[j_], acc[j_][n_]); } } } while (0)
#define MOE_BAR() __builtin_amdgcn_s_barrier()
    MOE_DMA(0, 0); MOE_DMA(1, 1);
    MOE_LOADA0(A0, 0, 0); MOE_LOADA0(A1, 0, 1);
    asm volatile("s_waitcnt vmcnt(0)" ::: "memory");
    MOE_BAR();
    MOE_CONVERT(0, 0);
    asm volatile("s_waitcnt lgkmcnt(0)" ::: "memory");
    MOE_BAR();
    int slot1 = 1, slot2 = 2;
#pragma unroll 1
    for (int sl = 0; sl < NSL; ++sl) {
#pragma unroll 1
    for (int tt = 0; tt < NK; ++tt) {
        const int t = sl * NK + tt;
        const unsigned bo = (unsigned)(t & 1) * 16384u;
        const int t1 = t + 1 < NKT ? t + 1 : NKT - 1, t2 = t + 2 < NKT ? t + 2 : NKT - 1;
        MOE_DMA(t2, slot2);
        MOE_WAITA(A0, NA + 4);
        MOE_COMPUTE(A0, bo, 0);
        MOE_WAITA(A1, 4);
        if (NA == 0) asm volatile("s_waitcnt vmcnt(4)" ::: "memory");
        MOE_BAR();
        MOE_LOADA(A0, t1, 0); MOE_CONVERT(slot1, bo ^ 16384u);
        MOE_COMPUTE(A1, bo, 1);
        MOE_LOADA(A1, t1, 1);
        asm volatile("s_waitcnt lgkmcnt(0)" ::: "memory");
        MOE_BAR();
        slot1 = slot2; slot2 = slot2 == 2 ? 0 : slot2 + 1;
    }
    MOE_WAITA(A0, 0); MOE_WAITA(A1, 0);
    if (NA == 0) asm volatile("s_waitcnt vmcnt(0)" ::: "memory");
    if (NA > 0) {
        const int tid2 = tid_(), fr2 = tid2 & 15, fq2 = (tid2 & 63) >> 4; const int wid2 = __builtin_amdgcn_readfirstlane(tid2 >> 6);
#pragma unroll
        for (int j = 0; j < NA1; ++j) {
            const int pos = row0 + 16 * (wid2 + 8 * j) + fr2;
            if (pos < cnt) {
                if (MODE == 0) {
                    unsigned char* orow = p.ws + OFF_HE + (size_t)(cstart + pos) * 256 + 64 * s + 8 * fq2;
#pragma unroll
                    for (int g = 0; g < 2; ++g) {
                        float h[8];
#pragma unroll
                        for (int b = 0; b < 2; ++b)
#pragma unroll
                            for (int i = 0; i < 4; ++i) h[4 * b + i] = siluf_(acc[j][2 * g + b][i]) * acc[j][4 + 2 * g + b][i];
                        *(u32x2*)(orow + 32 * g) = (u32x2){pk4_fp8(h[0], h[1], h[2], h[3]), pk4_fp8(h[4], h[5], h[6], h[7])};
                    }
                } else {
                    const float wt = ((const float*)(p.ws + OFF_WL))[(size_t)e * T_ + list_idx(so8, pos)];
                    unsigned char* orow = p.ws + OFF_YS + (size_t)(cstart + pos) * D_ + 128 * (NSL * s + sl) + 8 * fq2;
#pragma unroll
                    for (int g = 0; g < 4; ++g) {
                        const f32x4 v0 = acc[j][2 * g] * wt, v1 = acc[j][2 * g + 1] * wt;
                        *(u32x2*)(orow + 32 * g) = (u32x2){pk4_fp8(v0[0], v0[1], v0[2], v0[3]), pk4_fp8(v1[0], v1[1], v1[2], v1[3])};
                    }
                }
            }
        }
    }
    if (sl + 1 < NSL) {
#pragma unroll
        for (int j = 0; j < NA1; ++j)
#pragma unroll
            for (int n = 0; n < 8; ++n) acc[j][n] = (f32x4){0.f, 0.f, 0.f, 0.f};
    }
    }
#undef MOE_DMA
#undef MOE_CONVERT
#undef MOE_LOADA
#undef MOE_LOADA0
#undef MOE_WAITA
#undef MOE_COMPUTE
#undef MOE_BAR
}
template <int MODE, int XVV = 0>
__device__ __forceinline__ void moe_unit_pass(const P& p, int e, int s, int cnt, int cstart, int row0, unsigned char* smem, const int* so8) {
    const int wid = __builtin_amdgcn_readfirstlane(tid_() >> 6);
    const int nrows = (cnt - row0) < 512 ? (cnt - row0) : 512, ntile = (nrows + 15) >> 4;
    const int nact = ntile > wid ? (ntile - wid + 7) >> 3 : 0;
    if (nact == 4) moe_pass<MODE, 4, XVV>(p, smem, e, s, cnt, cstart, row0, so8);
    else if (nact == 3) moe_pass<MODE, 3, XVV>(p, smem, e, s, cnt, cstart, row0, so8);
    else if (nact == 2) moe_pass<MODE, 2, XVV>(p, smem, e, s, cnt, cstart, row0, so8);
    else if (nact == 1) moe_pass<MODE, 1, XVV>(p, smem, e, s, cnt, cstart, row0, so8);
    else moe_pass<MODE, 0, XVV>(p, smem, e, s, cnt, cstart, row0, so8);
}
template <int MODE, int XVV = 0>
__device__ __forceinline__ void ph_moe(const P& p, unsigned char* smem, int bid, int G) {
    int* cs = (int*)smem;
    const int* cnt = (const int*)(p.ws + OFF_CTL);
    __syncthreads();
    if (threadIdx.x < 256) { const int e = threadIdx.x; int a = 0;
#pragma unroll
        for (int q = 0; q < 8; ++q) { cs[1024 + 8 * e + q] = a; a += cnt[8 * e + q]; }
        cs[e] = a; }
    __syncthreads();
    if (threadIdx.x == 0) { int a = 0, mx = 0; for (int e = 0; e < 256; ++e) { const int c = cs[e]; cs[256 + e] = a; a += c; mx = c > mx ? c : mx; } cs[512] = mx; }
    __syncthreads();
    constexpr int NS = MODE == 0 ? 4 : 8 / MOE_NSL, NU1 = 256 * NS;
    const int NU = ((cs[512] + 511) >> 9) * NU1;
    unsigned* qctr = (unsigned*)(p.ws + OFF_CTL) + 2560 + MODE + (XVV ? 2 : 0);
    int u = bid;
#pragma unroll 1
    while (u < NU) {
        const int pass = u / NU1, r = u - pass * NU1;
        int e, s;
        if ((G & 63) == 0 && r < (NU1 / G) * G) { const int x = r & 7, y = (r >> 3) % (G >> 3), rnd = r / G; s = y % NS; e = rnd * (G / NS) + x * (G / (8 * NS)) + y / NS; }
        else { e = r / NS; s = r % NS; }
        const int c = cs[e], c0 = cs[256 + e];
        const bool pre = u + 2 * G < NU; int nxt = 0;
        if (pre && threadIdx.x == 0) nxt = G + (int)__hip_atomic_fetch_add(qctr, 1u, __ATOMIC_RELAXED, __HIP_MEMORY_SCOPE_AGENT);
        if (c > pass * 512) moe_unit_pass<MODE, XVV>(p, e, s, c, c0, pass * 512, smem + 12288, cs + 1024 + 8 * e);
        __syncthreads();
        if (threadIdx.x == 0) cs[513] = pre ? nxt : G + (int)__hip_atomic_fetch_add(qctr, 1u, __ATOMIC_RELAXED, __HIP_MEMORY_SCOPE_AGENT);
        __syncthreads();
        u = cs[513];
    }
}
template <bool PROBE = false>
__device__ __forceinline__ void ph_comb(const P& p, unsigned char* smem, int bid, int G) {
    int* cs = (int*)smem;
    const int* cnt = (const int*)(p.ws + OFF_CTL);
    __syncthreads();
    if (threadIdx.x < 256) { const int e = threadIdx.x; int a = 0;
#pragma unroll
        for (int q = 0; q < 8; ++q) { cs[256 + 8 * e + q] = a; a += cnt[8 * e + q]; }
        cs[e] = a; }
    __syncthreads();
    if (threadIdx.x == 0) { int a = 0; for (int e = 0; e < 256; ++e) { const int c = cs[e]; cs[e] = a; a += c; } }
    __syncthreads();
    if (threadIdx.x < 256) { const int e = threadIdx.x, c0 = cs[e];
#pragma unroll
        for (int q = 0; q < 8; ++q) cs[256 + 8 * e + q] += c0; }
    __syncthreads();
    const int tid = tid_(), wid = tid >> 6, lane = tid & 63;
    const float* gate = (const float*)(p.ws + OFF_MOD) + 5120; const bf16_t* SD = (const bf16_t*)(p.ws + OFF_SD); const unsigned char* YS = p.ws + OFF_YS;
    const int* EIDX = (const int*)(p.ws + OFF_EIDX); const int* POSI = (const int*)(p.ws + OFF_POSI);
    const int t0 = bid * 8 + wid, tstep = G * 8;
#pragma unroll 1
    for (int tb = t0; tb < T_; tb += 8 * tstep) {
        const int tl = tb + tstep * (lane >> 3);
        int slotv = 0;
        if (tl < T_) slotv = cs[256 + 8 * EIDX[tl * 8 + (lane & 7)] + ((tl >> 3) & 7)] + POSI[tl * 8 + (lane & 7)];
        u32x2 y[2][2][8]; u32x4 sd[2][2];
#define COMB_LOAD(i, b) do { const int t_ = tb + tstep * (i); if (t_ < T_) { _Pragma("unroll") for (int k_ = 0; k_ < 8; ++k_) { const int sl_ = __builtin_amdgcn_readlane(slotv, 8 * (i) + k_); \
            const unsigned char* yr_ = YS + (size_t)sl_ * D_ + 8 * lane; y[b][0][k_] = *(const u32x2*)yr_; y[b][1][k_] = *(const u32x2*)(yr_ + 512); } \
            sd[b][0] = *(const u32x4*)(SD + (size_t)t_ * D_ + 8 * lane); sd[b][1] = *(const u32x4*)(SD + (size_t)t_ * D_ + 512 + 8 * lane); } } while (0)
#define COMB_ACC(i, b) do { const int t_ = tb + tstep * (i); if (t_ < T_) { _Pragma("unroll") for (int j_ = 0; j_ < 2; ++j_) { const int c_ = 512 * j_ + 8 * lane; float a_[8]; \
            _Pragma("unroll") for (int q_ = 0; q_ < 4; ++q_) { a_[2 * q_] = bflo(sd[b][j_][q_]); a_[2 * q_ + 1] = bfhi(sd[b][j_][q_]); } \
            _Pragma("unroll") for (int k_ = 0; k_ < 8; ++k_) { _Pragma("unroll") for (int q_ = 0; q_ < 2; ++q_) { \
                const f32x2v lo_ = __builtin_amdgcn_cvt_pk_f32_fp8((int)y[b][j_][k_][q_], false), hi_ = __builtin_amdgcn_cvt_pk_f32_fp8((int)y[b][j_][k_][q_], true); \
                a_[4 * q_] += lo_[0]; a_[4 * q_ + 1] += lo_[1]; a_[4 * q_ + 2] += hi_[0]; a_[4 * q_ + 3] += hi_[1]; } } \
            float* o_ = p.out + (size_t)t_ * D_ + c_; float* w_ = PROBE ? (float*)(p.ws + OFF_OGLA) + (size_t)t_ * D_ + c_ : o_; \
            const f32x4 x0_ = *(const f32x4*)o_, x1_ = *(const f32x4*)(o_ + 4), g0_ = *(const f32x4*)(gate + c_), g1_ = *(const f32x4*)(gate + c_ + 4); \
            *(f32x4*)w_ = x0_ + g0_ * (f32x4){a_[0], a_[1], a_[2], a_[3]}; *(f32x4*)(w_ + 4) = x1_ + g1_ * (f32x4){a_[4], a_[5], a_[6], a_[7]}; } } } while (0)
        COMB_LOAD(0, 0);
#pragma unroll
        for (int i = 0; i < 8; i += 2) {
            COMB_LOAD(i + 1, 1); COMB_ACC(i, 0);
            if (i + 2 < 8) COMB_LOAD(i + 2, 0);
            COMB_ACC(i + 1, 1);
        }
#undef COMB_LOAD
#undef COMB_ACC
    }
}

extern __shared__ __attribute__((aligned(16))) unsigned char smem_dyn[];
#ifndef MK_FUSED
#define MK_FUSED 1
#endif
constexpr int LDS_BYTES = 142 * 1024;

#if MK_FUSED
__global__ void __launch_bounds__(NTHR, 2) k_fused(P p) {
    unsigned char* smem = smem_dyn + 64;
    if (threadIdx.x == 0) *(u32x4*)smem_dyn = (u32x4){0u, 0u, 0u, 0u};
    __syncthreads();
    XcdBarrier bar = xcd_barrier_post((unsigned*)(p.ws + OFF_BAR), (volatile LAS unsigned*)smem_dyn);
    const int bid = blockIdx.x, G = gridDim.x;
#ifndef DUP
#define DUP 0
#endif
#define RUN(bit, call) do { call; if (DUP & (1 << (bit))) { __syncthreads(); call; } } while (0)
    RUN(0, phase_p0(p, smem, bid, G));            xcd_barrier(bar);
    RUN(1, ph_norm1(p, bid, G)); phase_conv(p, smem, bid, G, 0, NT_WIN);                  xcd_barrier(bar);
    RUN(2, ph_inproj(p, smem, bid, G));           xcd_barrier(bar);
    RUN(11, ph_prep(p, smem, bid, G));            xcd_barrier(bar);
    RUN(8, ph_gla<false>(p, smem, bid, G));       xcd_barrier(bar);
    RUN(9, phase_g2(p, bid, G)); phase_conv(p, smem, bid, G, NT_WIN, NT_ALL);                  xcd_barrier(bar);
    RUN(10, ph_gla<true>(p, smem, bid, G));
#ifndef ATTP
#define ATTP 0
#endif
    if (ATTP) { ph_att<ATTP>(p, smem, bid, G); __syncthreads(); }
    RUN(4, ph_att<0>(p, smem, bid, G));           xcd_barrier(bar);
    RUN(5, ph_b1(p, smem, bid, G));               xcd_barrier(bar);
    RUN(5, ph_b2(p, smem, bid, G));               xcd_barrier(bar);
    RUN(1, ph_norm2(p, bid, G));                  xcd_barrier(bar);
    RUN(5, ph_f1(p, smem, bid, G));               xcd_barrier(bar);
    ph_route(p, smem, bid, G);                    xcd_barrier(bar);
#ifndef MOEP
#define MOEP 0
#endif
    if (MOEP & 1) { ph_moe<0, (XV ? XV : 4)>(p, smem, bid, G); __syncthreads(); }
    ph_moe<0>(p, smem, bid, G);                   xcd_barrier(bar);
    if (MOEP & 2) { ph_moe<1, (XV ? XV : 4)>(p, smem, bid, G); __syncthreads(); }
    ph_moe<1>(p, smem, bid, G);                   xcd_barrier(bar);
#ifndef CBP
#define CBP 0
#endif
    if (CBP) { ph_comb<true>(p, smem, bid, G); __syncthreads(); }
    ph_comb<false>(p, smem, bid, G);
}
#else
__global__ void __launch_bounds__(NTHR) k_p0(P p) { phase_p0(p, smem_dyn, blockIdx.x, gridDim.x); }
__global__ void __launch_bounds__(NTHR) k_norm1(P p) { ph_norm1(p, blockIdx.x, gridDim.x); phase_conv(p, smem_dyn, blockIdx.x, gridDim.x, 0, NT_WIN); }
__global__ void __launch_bounds__(NTHR) k_inproj(P p) { ph_inproj(p, smem_dyn, blockIdx.x, gridDim.x); }
__global__ void __launch_bounds__(NTHR) k_prep(P p) { ph_prep(p, smem_dyn, blockIdx.x, gridDim.x); }
__global__ void __launch_bounds__(NTHR) k_g1(P p) { ph_gla<false>(p, smem_dyn, blockIdx.x, gridDim.x); }
__global__ void __launch_bounds__(NTHR) k_g2(P p) { phase_g2(p, blockIdx.x, gridDim.x); phase_conv(p, smem_dyn, blockIdx.x, gridDim.x, NT_WIN, NT_ALL); }
__global__ void __launch_bounds__(NTHR) k_g3(P p) { ph_gla<true>(p, smem_dyn, blockIdx.x, gridDim.x); }
__global__ void __launch_bounds__(NTHR) k_att(P p) { ph_att<0>(p, smem_dyn, blockIdx.x, gridDim.x); }
__global__ void __launch_bounds__(NTHR) k_b1(P p) { ph_b1(p, smem_dyn, blockIdx.x, gridDim.x); }
__global__ void __launch_bounds__(NTHR) k_b2(P p) { ph_b2(p, smem_dyn, blockIdx.x, gridDim.x); }
__global__ void __launch_bounds__(NTHR) k_norm2(P p) { ph_norm2(p, blockIdx.x, gridDim.x); }
__global__ void __launch_bounds__(NTHR) k_f1(P p) { ph_f1(p, smem_dyn, blockIdx.x, gridDim.x); }
__global__ void __launch_bounds__(NTHR) k_route(P p) { ph_route(p, smem_dyn, blockIdx.x, gridDim.x); }
__global__ void __launch_bounds__(NTHR) k_m1(P p) { ph_moe<0>(p, smem_dyn, blockIdx.x, gridDim.x); }
__global__ void __launch_bounds__(NTHR) k_m2(P p) { ph_moe<1>(p, smem_dyn, blockIdx.x, gridDim.x); }
__global__ void __launch_bounds__(NTHR) k_comb(P p) { ph_comb<false>(p, smem_dyn, blockIdx.x, gridDim.x); }
#endif

extern "C" void kernel_launch(void* const* d_in, const int* in_sizes, int n_in, void* d_out, int out_size, void* d_ws, size_t ws_size, hipStream_t stream) {
    P p{};
    p.x = (const float*)d_in[0]; p.c = (const float*)d_in[1]; p.pos = (const int*)d_in[2]; p.w_ada = (const float*)d_in[3]; p.b_ada = (const float*)d_in[4]; p.norm1_g = (const float*)d_in[5];
    p.w_in = (const float*)d_in[6]; p.gla_w_a2 = (const float*)d_in[7]; p.gla_b_a = (const float*)d_in[8]; p.gla_onorm_g = (const float*)d_in[9]; p.qn_g = (const float*)d_in[10]; p.kn_g = (const float*)d_in[11];
    p.lq1 = (const float*)d_in[12]; p.lk1 = (const float*)d_in[13]; p.lq2 = (const float*)d_in[14]; p.lk2 = (const float*)d_in[15]; p.subln_g = (const float*)d_in[16];
    p.w_bg = (const float*)d_in[17]; p.w_bd = (const float*)d_in[18]; p.w_out = (const float*)d_in[19]; p.norm2_g = (const float*)d_in[20]; p.w_router = (const float*)d_in[21]; p.router_bias = (const float*)d_in[22];
    p.w_eg = (const float*)d_in[23]; p.w_eu = (const float*)d_in[24]; p.w_ed = (const float*)d_in[25]; p.w_sg = (const float*)d_in[26]; p.w_su = (const float*)d_in[27]; p.w_sd = (const float*)d_in[28];
    p.out = (float*)d_out; p.ws = (unsigned char*)d_ws;
    for (int i = 0; i < 8; ++i) p.invf[i] = (float)pow(500000.0, -(double)i / 8.0);
    (void)hipMemsetAsync(d_ws, 0, 64 << 10, stream);
#if MK_FUSED
    static int grid = 0;
    if (!grid) {
        int dev = 0, cus = 0, per_cu = 0;
        (void)hipGetDevice(&dev);
        (void)hipDeviceGetAttribute(&cus, hipDeviceAttributeMultiprocessorCount, dev);
        (void)hipFuncSetAttribute((const void*)k_fused, hipFuncAttributeMaxDynamicSharedMemorySize, LDS_BYTES);
        (void)hipOccupancyMaxActiveBlocksPerMultiprocessor(&per_cu, (const void*)k_fused, NTHR, LDS_BYTES);
        if (cus <= 0) cus = 256;
        grid = cus * (per_cu < 1 ? 1 : 1);
    }
    k_fused<<<grid, NTHR, LDS_BYTES, stream>>>(p);
#else
    static bool attr_done = false;
    if (!attr_done) { (void)hipFuncSetAttribute((const void*)k_g3, hipFuncAttributeMaxDynamicSharedMemorySize, 88 * 1024); attr_done = true; }
    const int G = 256;
    k_p0<<<G, NTHR, 32 * 1024, stream>>>(p);
    k_norm1<<<G, NTHR, 32 * 1024, stream>>>(p);
    k_inproj<<<G, NTHR, 0, stream>>>(p);
    k_prep<<<G, NTHR, 24 * 1024, stream>>>(p);
    k_g1<<<G, NTHR, 0, stream>>>(p);
    k_g2<<<G, NTHR, 32 * 1024, stream>>>(p);
    k_g3<<<G, NTHR, 88 * 1024, stream>>>(p);
    k_att<<<G, NTHR, 0, stream>>>(p);
    k_b1<<<G, NTHR, 0, stream>>>(p);
    k_b2<<<G, NTHR, 0, stream>>>(p);
    k_norm2<<<G, NTHR, 0, stream>>>(p);
    k_f1<<<G, NTHR, 0, stream>>>(p);
    k_route<<<G, NTHR, 0, stream>>>(p);
    k_m1<<<G, NTHR, 12288, stream>>>(p);
    k_m2<<<G, NTHR, 12288, stream>>>(p);
    k_comb<<<G, NTHR, 4096, stream>>>(p);
#endif
}
```

```cpp
#include <hip/hip_runtime.h>
#include <stdint.h>
#include <math.h>

#define LAS __attribute__((address_space(3)))
typedef unsigned short bf16_t;
typedef short bf16x8 __attribute__((ext_vector_type(8)));
typedef float f32x4 __attribute__((ext_vector_type(4)));
typedef float f32x16 __attribute__((ext_vector_type(16)));
typedef unsigned u32x4 __attribute__((ext_vector_type(4)));
typedef unsigned u32x2 __attribute__((ext_vector_type(2)));

constexpr int T_ = 16384, D_ = 1024, NPROJ = 8192, NTHR = 512;
constexpr size_t MiB = (size_t)1 << 20;
constexpr size_t OFF_CTL = 0, OFF_MOD = 64 << 10, OFF_WAT = 96 << 10, OFF_DEC = 128 << 10, OFF_EIDX = 1 * MiB, OFF_POSI = 1 * MiB + (512 << 10),
    OFF_WINT = 2 * MiB, OFF_WBG = 18 * MiB, OFF_WBD = 20 * MiB, OFF_WO = 22 * MiB, OFF_WF = 24 * MiB, OFF_WSD = 25 * MiB + (512 << 10), OFF_WGU = 26 * MiB,
    OFF_WD = 282 * MiB, OFF_PROJ = 410 * MiB, OFF_H = 666 * MiB, OFF_VT = 698 * MiB, OFF_VTG = 730 * MiB, OFF_KDT = 762 * MiB, OFF_LOC = 778 * MiB,
    OFF_CARRY = 810 * MiB, OFF_OGLA = 842 * MiB, OFF_ODIFF = 874 * MiB, OFF_MERGED = 906 * MiB,
    OFF_LOGITS = 698 * MiB, OFF_HS = 714 * MiB, OFF_SD = 722 * MiB, OFF_TOKL = 754 * MiB, OFF_WL = 770 * MiB, OFF_HE = 786 * MiB, OFF_YS = OFF_PROJ, OFF_H2F8 = 906 * MiB, OFF_Q8 = 26 * MiB, OFF_K8 = 42 * MiB, OFF_V8T = 58 * MiB;
constexpr int C_GQ = 0, C_GK = 512, C_GV = 1024, C_GG = 2048, C_DQ = 3072, C_DK = 4096, C_DV = 5120, C_MGL = 6144, C_MGD = 7168;
constexpr float EPS = 1e-6f;

struct P {
    const float *x, *c; const int* pos;
    const float *w_ada, *b_ada, *norm1_g, *w_in, *gla_w_a2, *gla_b_a, *gla_onorm_g, *qn_g, *kn_g, *lq1, *lk1, *lq2, *lk2, *subln_g, *w_bg, *w_bd, *w_out, *norm2_g,
        *w_router, *router_bias, *w_eg, *w_eu, *w_ed, *w_sg, *w_su, *w_sd;
    float* out; unsigned char* ws;
    float invf[8];
};

__device__ __forceinline__ unsigned f2bf(float f) { unsigned u = __float_as_uint(f); return (u + 0x7fffu + ((u >> 16) & 1u)) >> 16; }
__device__ __forceinline__ float bf2f(unsigned b) { return __uint_as_float(b << 16); }
typedef float f32x2_t __attribute__((ext_vector_type(2))); typedef __bf16 bf16x2_t __attribute__((ext_vector_type(2)));
__device__ __forceinline__ unsigned pk2(float lo, float hi) { const f32x2_t v = {lo, hi}; return __builtin_bit_cast(unsigned, __builtin_convertvector(v, bf16x2_t)); }
__device__ __forceinline__ float bflo(unsigned w) { return __uint_as_float(w << 16); }
__device__ __forceinline__ float bfhi(unsigned w) { return __uint_as_float(w & 0xffff0000u); }
__device__ __forceinline__ float sigmoidf_(float z) { return 1.0f / (1.0f + __expf(-z)); }
__device__ __forceinline__ float siluf_(float z) { return z / (1.0f + __expf(-z)); }
__device__ __forceinline__ float wave_sum(float v) {
#pragma unroll
    for (int o = 32; o >= 1; o >>= 1) v += __shfl_xor(v, o);
    return v;
}
__device__ __forceinline__ int tid_() { int t = threadIdx.x; asm volatile("" : "+v"(t)); return t; }
typedef float f32x2v __attribute__((ext_vector_type(2)));
__device__ __forceinline__ unsigned pk4_fp8(float a, float b, float c, float d) { int w = __builtin_amdgcn_cvt_pk_fp8_f32(a, b, 0, false); w = __builtin_amdgcn_cvt_pk_fp8_f32(c, d, w, true); return (unsigned)w; }
__device__ __forceinline__ bf16x8 fp8x8_to_bf16x8(u32x2 w) {
    const f32x2v a = __builtin_amdgcn_cvt_pk_f32_fp8((int)w[0], false), b = __builtin_amdgcn_cvt_pk_f32_fp8((int)w[0], true), c = __builtin_amdgcn_cvt_pk_f32_fp8((int)w[1], false), d = __builtin_amdgcn_cvt_pk_f32_fp8((int)w[1], true);
    const u32x4 r = {pk2(a[0], a[1]), pk2(b[0], b[1]), pk2(c[0], c[1]), pk2(d[0], d[1])}; return __builtin_bit_cast(bf16x8, r); }
#define MFMA16(a, b, c) __builtin_amdgcn_mfma_f32_16x16x32_bf16((a), (b), (c), 0, 0, 0)
#define MFMA32(a, b, c) __builtin_amdgcn_mfma_f32_32x32x16_bf16((a), (b), (c), 0, 0, 0)
__device__ __forceinline__ int crow(int reg, int hi) { return (reg & 3) + 8 * (reg >> 2) + 4 * hi; }

namespace pg8 {
#define PG8_LAS __attribute__((address_space(3)))
constexpr int BM = 256, BK = 64, HALF = 128, HTB = HALF * BK * 2  , STAGE_BYTES = 8 * HTB, NXCD = 8, WGM = 8;

__host__ __device__ __forceinline__ int lds_byte(int r, int c) { const int st = (r >> 4) * 2 + (c >> 5), rr = r & 15, cc = c & 31, ob = rr * 64 + cc * 2; return st * 1024 + (ob ^ (((ob >> 9) & 1) << 5)); }
__host__ __device__ __forceinline__ void stage_rc(int b, int& R, int& C) { const int st = b / 1024, sb = b % 1024, swz = sb ^ (((sb >> 9) & 1) << 5); R = (st >> 1) * 16 + swz / 64; C = (st & 1) * 32 + (swz % 64) / 2; }
__host__ __device__ __forceinline__ int perm32(int rho) { const int n = rho >> 4, i = rho & 15; return 8 * (i >> 2) + 4 * n + (i & 3); }
struct Unit { int pm, pn; };
struct Gemm { const bf16_t* A; const bf16_t* Bt; int M, N, K; };

struct StaticOrder {
    int nM, nN, nwg, G, c;
    __host__ __device__ void init(int M, int N, int G_, int c_) { nM = M / BM; nN = N / BM; nwg = nM * nN; G = G_; c = c_; }
    __host__ __device__ bool next(int i, Unit& u) const {
        const long L = (long)i * G + c; if (L >= nwg) return false;
        int wgid = (int)L; { const int q = nwg / NXCD, r = nwg % NXCD, xcd = wgid % NXCD, off = wgid / NXCD; wgid = (xcd < r ? xcd * (q + 1) : r * (q + 1) + (xcd - r) * q) + off; }
        const int nig = WGM * nN, gid = wgid / nig, fm = gid * WGM, gsz = (nM - fm) < WGM ? (nM - fm) : WGM;
        u.pm = fm + ((wgid % nig) % gsz); u.pn = (wgid % nig) / gsz; return true;
    }
    __device__ __forceinline__ void a_ready(const Unit&) const {}
    __device__ __forceinline__ void done(const Unit&) const {}
};
__device__ __forceinline__ void glds16_s(unsigned voff, const void* sbase, unsigned lds_dst) { unsigned keep;
    asm volatile("s_nop 4\n\ts_mov_b32 %0, m0\n\ts_mov_b32 m0, %3\n\ts_nop 0\n\tglobal_load_lds_dwordx4 %1, %2\n\ts_mov_b32 m0, %0" : "=&s"(keep) : "v"(voff), "s"(sbase), "s"(lds_dst) : "memory"); }
typedef int i32x8 __attribute__((ext_vector_type(8)));
typedef int i32x4 __attribute__((ext_vector_type(4)));
__device__ __forceinline__ i32x8 cat16(bf16x8 lo, bf16x8 hi) { return __builtin_shufflevector(__builtin_bit_cast(i32x4, lo), __builtin_bit_cast(i32x4, hi), 0, 1, 2, 3, 4, 5, 6, 7); }
template <class Epi, class Sched, bool ALIGN_EPI = false, bool SP2 = false, bool F8 = false>
__device__ __forceinline__ void gemm_phase(PG8_LAS unsigned char* lds, const Gemm g, const Sched& S, const Epi& E) {
    const int tid = tid_(), wid = __builtin_amdgcn_readfirstlane(tid >> 6), lane = tid & 63, wr = wid >> 2, wc = wid & 3, fr = lane & 15, fq = lane >> 4;
    const int K = g.K, nt = K / BK;
    unsigned voffA[2], voffB[2];
#pragma unroll
    for (int i = 0; i < 2; ++i) { int R, C; stage_rc(tid * 16 + i * 8192, R, C); const int Rb = Epi::PERM ? ((R & ~31) + perm32(R & 31)) : R;
        voffA[i] = (unsigned)(R * K + C) * 2u; voffB[i] = (unsigned)(Rb * K + C) * 2u; }
    const size_t kstep = (size_t)(BK * 2);
    const size_t hstep = (size_t)HALF * K * 2;
    const size_t tstep = 2 * hstep;
    const unsigned ldsw = (unsigned)wid * 1024u;
    const unsigned ldsb0 = (unsigned)(uintptr_t)lds;
    const int aoff = lds_byte(wr * 64 + fr, fq * 8), boff = lds_byte(wc * 32 + fr, fq * 8);
#define PG8_SA(b, h) (((b) * 2 + (h)) * HTB)
#define PG8_SB(b, h) ((4 + (b) * 2 + (h)) * HTB)
#define PG8_STAGE(bufoff, gbase, voff) do { _Pragma("unroll") for (int _i = 0; _i < 2; ++_i) { \
        if constexpr (F8) { int R_, C_; stage_rc((tid_() & 511) * 16 + _i * 8192, R_, C_); const bool isB_ = &(voff)[0] == &voffB[0]; if (isB_ && Epi::PERM) R_ = (R_ & ~31) + perm32(R_ & 31); \
            glds16_s((unsigned)(R_ * K + C_) * 2u, (const void*)(gbase), (unsigned)__builtin_amdgcn_readfirstlane(ldsb0 + (unsigned)(bufoff) + ldsw + _i * 8192)); } \
        else __builtin_amdgcn_global_load_lds((const unsigned*)((const char*)(gbase) + (voff)[_i]), (PG8_LAS unsigned*)(lds + (bufoff) + ldsw + _i * 8192), 16, 0, 0); } } while (0)
#define PG8_LDA(dst, b, h) do { _Pragma("unroll") for (int m = 0; m < 4; ++m) { if constexpr (F8) dst##8[m] = cat16(*(const PG8_LAS bf16x8*)(lds + PG8_SA(b, h) + aoff + m * 2048), *(const PG8_LAS bf16x8*)(lds + PG8_SA(b, h) + aoff + m * 2048 + 1024)); \
        else { _Pragma("unroll") for (int k = 0; k < 2; ++k) dst[m][k] = *(const PG8_LAS bf16x8*)(lds + PG8_SA(b, h) + aoff + m * 2048 + k * 1024); } } } while (0)
#define PG8_LDB(dst, b, h) do { _Pragma("unroll") for (int n = 0; n < 2; ++n) { if constexpr (F8) dst##8[n] = cat16(*(const PG8_LAS bf16x8*)(lds + PG8_SB(b, h) + boff + n * 2048), *(const PG8_LAS bf16x8*)(lds + PG8_SB(b, h) + boff + n * 2048 + 1024)); \
        else { _Pragma("unroll") for (int k = 0; k < 2; ++k) dst[n][k] = *(const PG8_LAS bf16x8*)(lds + PG8_SB(b, h) + boff + n * 2048 + k * 1024); } } } while (0)
#define PG8_MMA(ai, bj, At, Bt) do { __builtin_amdgcn_s_setprio(1); if constexpr (F8) { _Pragma("unroll") for (int m = 0; m < 4; ++m) _Pragma("unroll") for (int n = 0; n < 2; ++n) \
        acc[ai][bj][m][n] = __builtin_amdgcn_mfma_scale_f32_16x16x128_f8f6f4(Bt##8[n], At##8[m], acc[ai][bj][m][n], 0, 0, 0, 0x7A7A7A7A, 0, 0x7F7F7F7F); } else { \
        _Pragma("unroll") for (int m = 0; m < 4; ++m) _Pragma("unroll") for (int n = 0; n < 2; ++n) _Pragma("unroll") for (int k = 0; k < 2; ++k) \
        acc[ai][bj][m][n] = __builtin_amdgcn_mfma_f32_16x16x32_bf16(Bt[n][k], At[m][k], acc[ai][bj][m][n], 0, 0, 0); } __builtin_amdgcn_s_setprio(0); } while (0)
#define PG8_WAIT_V(n) asm volatile("s_waitcnt vmcnt(" #n ")" ::: "memory")
#define PG8_WAIT_L(n) asm volatile("s_waitcnt lgkmcnt(" #n ")" ::: "memory")
#define PG8_BAR __builtin_amdgcn_s_barrier()
#define PG8_SCHED __builtin_amdgcn_sched_barrier(0)
    Unit cur, nxt; int ui = 0;
    if (!S.next(0, cur)) return;
    f32x4 acc[2][2][4][2];
#pragma unroll
    for (int a = 0; a < 2; ++a)
#pragma unroll
        for (int b = 0; b < 2; ++b)
#pragma unroll
            for (int m = 0; m < 4; ++m)
#pragma unroll
                for (int n = 0; n < 2; ++n) acc[a][b][m][n] = (f32x4){0.f, 0.f, 0.f, 0.f};
    bf16x8 At[4][2], B0[2][2], B1[2][2]; i32x8 At8[4], B08[2], B18[2];
    const char* cA = (const char*)g.A + (size_t)cur.pm * tstep; const char* cB = (const char*)g.Bt + (size_t)cur.pn * tstep;
    S.a_ready(cur);
    if constexpr (SP2) {
        PG8_STAGE(PG8_SB(0, 0), cB, voffB); PG8_STAGE(PG8_SB(0, 1), cB + hstep, voffB); PG8_STAGE(PG8_SA(0, 0), cA, voffA); PG8_STAGE(PG8_SA(0, 1), cA + hstep, voffA);
        if (wr == 1) PG8_BAR;
        PG8_WAIT_V(2); PG8_BAR;
        PG8_STAGE(PG8_SB(1, 0), cB + kstep, voffB); PG8_STAGE(PG8_SA(1, 0), cA + kstep, voffA); PG8_STAGE(PG8_SB(1, 1), cB + hstep + kstep, voffB);
        PG8_WAIT_V(6); PG8_BAR;
    } else {
        PG8_STAGE(PG8_SB(0, 0), cB, voffB); PG8_STAGE(PG8_SA(0, 0), cA, voffA); PG8_STAGE(PG8_SB(0, 1), cB + hstep, voffB); PG8_STAGE(PG8_SA(0, 1), cA + hstep, voffA);
        if (wr == 1) PG8_BAR;
        PG8_WAIT_V(4); PG8_BAR;
        PG8_STAGE(PG8_SB(1, 0), cB + kstep, voffB); PG8_STAGE(PG8_SA(1, 0), cA + kstep, voffA); PG8_STAGE(PG8_SB(1, 1), cB + hstep + kstep, voffB);
        PG8_WAIT_V(6); PG8_BAR;
    }
    for (;;) {
        const bool has_next = S.next(ui + 1, nxt);
        const char* nA = has_next ? (const char*)g.A + (size_t)nxt.pm * tstep : cA; const char* nB = has_next ? (const char*)g.Bt + (size_t)nxt.pn * tstep : cB;
#pragma unroll 1
        for (int t = 0; t < nt; t += 2) {
            const bool last = (t == nt - 2);
            const char* a1 = cA + (size_t)(t + 1) * kstep;
            const char* a2 = last ? nA : cA + (size_t)(t + 2) * kstep; const char* b2 = last ? nB : cB + (size_t)(t + 2) * kstep;
            const char* a3 = a2 + kstep; const char* b3 = b2 + kstep;
            if (last && has_next) S.a_ready(nxt);
            if constexpr (SP2) {
            PG8_LDB(B0, 0, 0); PG8_LDB(B1, 0, 1); PG8_SCHED; PG8_LDA(At, 0, 0); PG8_STAGE(PG8_SA(1, 1), a1 + hstep, voffA);
            PG8_WAIT_V(8); PG8_WAIT_L(0); PG8_BAR; PG8_MMA(0, 0, At, B0); PG8_MMA(0, 1, At, B1); PG8_BAR; PG8_SCHED;
            PG8_LDA(At, 0, 1); PG8_STAGE(PG8_SB(0, 0), b2, voffB); PG8_STAGE(PG8_SB(0, 1), b2 + hstep, voffB); PG8_STAGE(PG8_SA(0, 0), a2, voffA);
            PG8_WAIT_V(8); PG8_WAIT_L(0); PG8_BAR; PG8_MMA(1, 0, At, B0); PG8_MMA(1, 1, At, B1); PG8_BAR; PG8_SCHED;
            PG8_LDB(B0, 1, 0); PG8_LDB(B1, 1, 1); PG8_SCHED; PG8_LDA(At, 1, 0); PG8_STAGE(PG8_SA(0, 1), a2 + hstep, voffA);
            PG8_WAIT_V(8); PG8_WAIT_L(0); PG8_BAR; PG8_MMA(0, 0, At, B0); PG8_MMA(0, 1, At, B1); PG8_BAR; PG8_SCHED;
            PG8_LDA(At, 1, 1); PG8_STAGE(PG8_SB(1, 0), b3, voffB); PG8_STAGE(PG8_SB(1, 1), b3 + hstep, voffB); PG8_STAGE(PG8_SA(1, 0), a3, voffA);
            PG8_WAIT_V(8); PG8_WAIT_L(0); PG8_BAR; PG8_MMA(1, 0, At, B0); PG8_MMA(1, 1, At, B1); PG8_BAR; PG8_SCHED;
            } else {
            PG8_LDB(B0, 0, 0); PG8_SCHED; PG8_LDA(At, 0, 0); PG8_STAGE(PG8_SA(1, 1), a1 + hstep, voffA);
            PG8_WAIT_L(8); PG8_BAR; PG8_WAIT_L(0); PG8_MMA(0, 0, At, B0); PG8_BAR; PG8_SCHED;
            PG8_LDB(B1, 0, 1); PG8_STAGE(PG8_SB(0, 0), b2, voffB);
            PG8_BAR; PG8_WAIT_L(0); PG8_MMA(0, 1, At, B1); PG8_BAR;
            PG8_LDA(At, 0, 1); PG8_STAGE(PG8_SA(0, 0), a2, voffA);
            PG8_BAR; PG8_WAIT_L(0); PG8_MMA(1, 0, At, B0); PG8_BAR; PG8_SCHED;
            PG8_STAGE(PG8_SB(0, 1), b2 + hstep, voffB);
            PG8_WAIT_V(6); PG8_BAR; PG8_MMA(1, 1, At, B1); PG8_BAR;
            PG8_LDB(B0, 1, 0); PG8_SCHED; PG8_LDA(At, 1, 0); PG8_STAGE(PG8_SA(0, 1), a2 + hstep, voffA);
            PG8_WAIT_L(8); PG8_BAR; PG8_WAIT_L(0); PG8_MMA(0, 0, At, B0); PG8_BAR; PG8_SCHED;
            PG8_LDB(B1, 1, 1); PG8_STAGE(PG8_SB(1, 0), b3, voffB);
            PG8_BAR; PG8_WAIT_L(0); PG8_MMA(0, 1, At, B1); PG8_BAR;
            PG8_LDA(At, 1, 1); PG8_STAGE(PG8_SA(1, 0), a3, voffA);
            PG8_BAR; PG8_WAIT_L(0); PG8_MMA(1, 0, At, B0); PG8_BAR; PG8_SCHED;
            PG8_STAGE(PG8_SB(1, 1), b3 + hstep, voffB);
            PG8_WAIT_V(6); PG8_BAR; PG8_MMA(1, 1, At, B1); PG8_BAR;
            }
        }
        if constexpr (ALIGN_EPI) { if (wr == 0) PG8_BAR; }
        if constexpr (!Epi::AFTER_DRAIN) { const int te_ = tid_() & 63; E(acc, cur, wr, wc, te_ & 15, te_ >> 4); S.done(cur); }
        if (!has_next) break;
#pragma unroll
        for (int a = 0; a < 2; ++a)
#pragma unroll
            for (int b = 0; b < 2; ++b)
#pragma unroll
                for (int m = 0; m < 4; ++m)
#pragma unroll
                    for (int n = 0; n < 2; ++n) acc[a][b][m][n] = (f32x4){0.f, 0.f, 0.f, 0.f};
        cur = nxt; cA = nA; cB = nB; ++ui;
        if constexpr (ALIGN_EPI) { if (wr == 1) PG8_BAR; }
    }
    PG8_WAIT_V(0);
    if constexpr (!ALIGN_EPI) { if (wr == 0) PG8_BAR; }
    PG8_BAR;
    if constexpr (Epi::AFTER_DRAIN) { E.fused(acc, cur, wr, wc, fr, fq, lds, wid, lane); S.done(cur); }
#undef PG8_SA
#undef PG8_SB
#undef PG8_STAGE
#undef PG8_LDA
#undef PG8_LDB
#undef PG8_MMA
#undef PG8_WAIT_V
#undef PG8_WAIT_L
#undef PG8_BAR
#undef PG8_SCHED
}
}
using pg8::Unit; using pg8::perm32;

template <class ARow, class Epi>
__device__ __forceinline__ void gemm_unit_direct(const bf16_t* __restrict__ A, const ARow& arow, const bf16_t* __restrict__ Btile, int K, const Epi& E, const Unit& u) {
    const int tid = tid_(), wid = tid >> 6, lane = tid & 63, wr = wid >> 2, wc = wid & 3, fr = lane & 15, fq = lane >> 4;
    f32x4 acc[2][2][4][2];
#pragma unroll
    for (int a = 0; a < 2; ++a)
#pragma unroll
        for (int b = 0; b < 2; ++b)
#pragma unroll
            for (int m = 0; m < 4; ++m)
#pragma unroll
                for (int n = 0; n < 2; ++n) acc[a][b][m][n] = (f32x4){0.f, 0.f, 0.f, 0.f};
    unsigned aoff[2][4], boff[2][2];
#pragma unroll
    for (int ai = 0; ai < 2; ++ai)
#pragma unroll
        for (int m = 0; m < 4; ++m) aoff[ai][m] = arow(128 * ai + 64 * wr + 16 * m + fr) + 8 * fq;
#pragma unroll
    for (int bj = 0; bj < 2; ++bj)
#pragma unroll
        for (int n = 0; n < 2; ++n) boff[bj][n] = (unsigned)(128 * bj + 32 * wc + perm32(16 * n + fr)) * (unsigned)K + 8 * fq;
#pragma unroll 1
    for (int k0 = 0; k0 < K; k0 += 32) {
        bf16x8 b[2][2];
#pragma unroll
        for (int bj = 0; bj < 2; ++bj)
#pragma unroll
            for (int n = 0; n < 2; ++n) b[bj][n] = *(const bf16x8*)(Btile + boff[bj][n] + k0);
#pragma unroll
        for (int ai = 0; ai < 2; ++ai) {
            bf16x8 a[4];
#pragma unroll
            for (int m = 0; m < 4; ++m) a[m] = *(const bf16x8*)(A + aoff[ai][m] + k0);
#pragma unroll
            for (int bj = 0; bj < 2; ++bj)
#pragma unroll
                for (int m = 0; m < 4; ++m)
#pragma unroll
                    for (int n = 0; n < 2; ++n) acc[ai][bj][m][n] = MFMA16(b[bj][n], a[m], acc[ai][bj][m][n]);
        }
    }
    E(acc, u, wr, wc, fr, fq);
}
struct RowLinear { unsigned row0, ld; __device__ __forceinline__ unsigned operator()(int r) const { return (row0 + (unsigned)r) * ld; } };

#define EPI_LOOP for (int ai = 0; ai < 2; ++ai) for (int m = 0; m < 4; ++m) for (int bj = 0; bj < 2; ++bj)
struct EpiStoreBf16 {
    static constexpr bool PERM = true, AFTER_DRAIN = false;
    bf16_t* O; int ld;
    __device__ __forceinline__ void operator()(const f32x4 (&acc)[2][2][4][2], const Unit& u, int wr, int wc, int fr, int fq) const {
#pragma unroll
        for (int ai = 0; ai < 2; ++ai)
#pragma unroll
            for (int m = 0; m < 4; ++m)
#pragma unroll
                for (int bj = 0; bj < 2; ++bj) {
                    const size_t row = (size_t)u.pm * 256 + 128 * ai + 64 * wr + 16 * m + fr; const int col = u.pn * 256 + 128 * bj + 32 * wc + 8 * fq;
                    const f32x4 v0 = acc[ai][bj][m][0], v1 = acc[ai][bj][m][1];
                    u32x4 w = {pk2(v0[0], v0[1]), pk2(v0[2], v0[3]), pk2(v1[0], v1[1]), pk2(v1[2], v1[3])};
                    *(u32x4*)(O + row * ld + col) = w;
                }
    }
};
struct EpiB1a {
    static constexpr bool PERM = true, AFTER_DRAIN = false;
    bf16_t* M1; const bf16_t* PROJ;
    __device__ __forceinline__ void operator()(const f32x4 (&acc)[2][2][4][2], const Unit& u, int wr, int wc, int fr, int fq) const {
#pragma unroll
        for (int ai = 0; ai < 2; ++ai)
#pragma unroll
            for (int m = 0; m < 4; ++m)
#pragma unroll
                for (int bj = 0; bj < 2; ++bj) {
                    const size_t row = (size_t)u.pm * 256 + 128 * ai + 64 * wr + 16 * m + fr; const int col = u.pn * 256 + 128 * bj + 32 * wc + 8 * fq;
                    const u32x4 g = *(const u32x4*)(PROJ + row * NPROJ + C_MGL + col);
                    const f32x4 v0 = acc[ai][bj][m][0], v1 = acc[ai][bj][m][1];
                    f32x4 o0 = {sigmoidf_(bflo(g[0])) * v0[0], sigmoidf_(bfhi(g[0])) * v0[1], sigmoidf_(bflo(g[1])) * v0[2], sigmoidf_(bfhi(g[1])) * v0[3]};
                    f32x4 o1 = {sigmoidf_(bflo(g[2])) * v1[0], sigmoidf_(bfhi(g[2])) * v1[1], sigmoidf_(bflo(g[3])) * v1[2], sigmoidf_(bfhi(g[3])) * v1[3]};
                    *(u32x4*)(M1 + row * D_ + col) = (u32x4){pk2(o0[0], o0[1]), pk2(o0[2], o0[3]), pk2(o1[0], o1[1]), pk2(o1[2], o1[3])};
                }
    }
};
struct EpiB1b {
    static constexpr bool PERM = true, AFTER_DRAIN = false;
    const bf16_t* M1; const bf16_t* PROJ; bf16_t* MERGED;
    __device__ __forceinline__ void operator()(const f32x4 (&acc)[2][2][4][2], const Unit& u, int wr, int wc, int fr, int fq) const {
#pragma unroll
        for (int ai = 0; ai < 2; ++ai)
#pragma unroll
            for (int m = 0; m < 4; ++m)
#pragma unroll
                for (int bj = 0; bj < 2; ++bj) {
                    const size_t row = (size_t)u.pm * 256 + 128 * ai + 64 * wr + 16 * m + fr; const int col = u.pn * 256 + 128 * bj + 32 * wc + 8 * fq;
                    const u32x4 g = *(const u32x4*)(PROJ + row * NPROJ + C_MGD + col);
                    const u32x4 mw = *(const u32x4*)(M1 + row * D_ + col); const f32x4 m0 = {bflo(mw[0]), bfhi(mw[0]), bflo(mw[1]), bfhi(mw[1])}, m1 = {bflo(mw[2]), bfhi(mw[2]), bflo(mw[3]), bfhi(mw[3])};
                    const f32x4 v0 = acc[ai][bj][m][0], v1 = acc[ai][bj][m][1];
                    f32x4 o0 = {m0[0] + sigmoidf_(bflo(g[0])) * v0[0], m0[1] + sigmoidf_(bfhi(g[0])) * v0[1], m0[2] + sigmoidf_(bflo(g[1])) * v0[2], m0[3] + sigmoidf_(bfhi(g[1])) * v0[3]};
                    f32x4 o1 = {m1[0] + sigmoidf_(bflo(g[2])) * v1[0], m1[1] + sigmoidf_(bfhi(g[2])) * v1[1], m1[2] + sigmoidf_(bflo(g[3])) * v1[2], m1[3] + sigmoidf_(bfhi(g[3])) * v1[3]};
                    *(u32x2*)((unsigned char*)MERGED + row * D_ + col) = (u32x2){pk4_fp8(o0[0], o0[1], o0[2], o0[3]), pk4_fp8(o1[0], o1[1], o1[2], o1[3])};
                }
    }
};
struct EpiB2 {
    static constexpr bool PERM = true, AFTER_DRAIN = false;
    const float* x; const float* gate; float* X1;
    __device__ __forceinline__ void operator()(const f32x4 (&acc)[2][2][4][2], const Unit& u, int wr, int wc, int fr, int fq) const {
#pragma unroll
        for (int ai = 0; ai < 2; ++ai)
#pragma unroll
            for (int m = 0; m < 4; ++m)
#pragma unroll
                for (int bj = 0; bj < 2; ++bj) {
                    const size_t row = (size_t)u.pm * 256 + 128 * ai + 64 * wr + 16 * m + fr; const int col = u.pn * 256 + 128 * bj + 32 * wc + 8 * fq;
#pragma unroll
                    for (int n = 0; n < 2; ++n) {
                        const f32x4 xv = *(const f32x4*)(x + row * D_ + col + 4 * n), gv = *(const f32x4*)(gate + col + 4 * n);
                        *(f32x4*)(X1 + row * D_ + col + 4 * n) = xv + gv * acc[ai][bj][m][n];
                    }
                }
    }
};
struct EpiF1 {
    static constexpr bool PERM = true, AFTER_DRAIN = false;
    float* LOGITS; bf16_t* HS;
    __device__ __forceinline__ void operator()(const f32x4 (&acc)[2][2][4][2], const Unit& u, int wr, int wc, int fr, int fq) const {
#pragma unroll
        for (int ai = 0; ai < 2; ++ai)
#pragma unroll
            for (int m = 0; m < 4; ++m) {
                const size_t row = (size_t)u.pm * 256 + 128 * ai + 64 * wr + 16 * m + fr;
                if (u.pn == 0) {
#pragma unroll
                    for (int bj = 0; bj < 2; ++bj)
#pragma unroll
                        for (int n = 0; n < 2; ++n) *(f32x4*)(LOGITS + row * 256 + 128 * bj + 32 * wc + 8 * fq + 4 * n) = acc[ai][bj][m][n];
                } else {
                    float h[8];
#pragma unroll
                    for (int n = 0; n < 2; ++n)
#pragma unroll
                        for (int i = 0; i < 4; ++i) h[4 * n + i] = siluf_(acc[ai][0][m][n][i]) * acc[ai][1][m][n][i];
                    u32x4 w = {pk2(h[0], h[1]), pk2(h[2], h[3]), pk2(h[4], h[5]), pk2(h[6], h[7])};
                    *(u32x4*)(HS + row * 256 + (u.pn - 1) * 128 + 32 * wc + 8 * fq) = w;
                }
            }
    }
};
struct EpiM1 {
    bf16_t* HE; int cstart, cnt;
    __device__ __forceinline__ void operator()(const f32x4 (&acc)[2][2][4][2], const Unit& u, int wr, int wc, int fr, int fq) const {
#pragma unroll
        for (int ai = 0; ai < 2; ++ai)
#pragma unroll
            for (int m = 0; m < 4; ++m) {
                const int pos = u.pm * 256 + 128 * ai + 64 * wr + 16 * m + fr;
                if (pos < cnt) {
                    float h[8];
#pragma unroll
                    for (int n = 0; n < 2; ++n)
#pragma unroll
                        for (int i = 0; i < 4; ++i) h[4 * n + i] = siluf_(acc[ai][0][m][n][i]) * acc[ai][1][m][n][i];
                    u32x4 w = {pk2(h[0], h[1]), pk2(h[2], h[3]), pk2(h[4], h[5]), pk2(h[6], h[7])};
                    *(u32x4*)(HE + (size_t)(cstart + pos) * 256 + u.pn * 128 + 32 * wc + 8 * fq) = w;
                }
            }
    }
};
struct EpiM2 {
    bf16_t* YS; const float* wl; int cstart, cnt;
    __device__ __forceinline__ void operator()(const f32x4 (&acc)[2][2][4][2], const Unit& u, int wr, int wc, int fr, int fq) const {
#pragma unroll
        for (int ai = 0; ai < 2; ++ai)
#pragma unroll
            for (int m = 0; m < 4; ++m) {
                const int pos = u.pm * 256 + 128 * ai + 64 * wr + 16 * m + fr;
                if (pos < cnt) {
                    const float wt = wl[pos];
#pragma unroll
                    for (int bj = 0; bj < 2; ++bj) {
                        const int col = u.pn * 256 + 128 * bj + 32 * wc + 8 * fq;
                        const f32x4 v0 = acc[ai][bj][m][0] * wt, v1 = acc[ai][bj][m][1] * wt;
                        u32x4 w = {pk2(v0[0], v0[1]), pk2(v0[2], v0[3]), pk2(v1[0], v1[1]), pk2(v1[2], v1[3])};
                        *(u32x4*)(YS + (size_t)(cstart + pos) * D_ + col) = w;
                    }
                }
            }
    }
};

__device__ __forceinline__ void conv_tile(const float* __restrict__ src, int ldN, int k0, int n0, bf16_t* __restrict__ dst, int ldK, int dst_row0, float* tile) {
    const int tid = tid_();
    {
        const int r = tid >> 4, c4 = tid & 15;
#pragma unroll
        for (int i = 0; i < 2; ++i) {
            const int row = r + 32 * i;
            const f32x4 v = *(const f32x4*)(src + (size_t)(k0 + row) * ldN + n0 + 4 * c4);
            tile[row * 65 + 4 * c4 + 0] = v[0]; tile[row * 65 + 4 * c4 + 1] = v[1]; tile[row * 65 + 4 * c4 + 2] = v[2]; tile[row * 65 + 4 * c4 + 3] = v[3];
        }
    }
    __syncthreads();
    {
        const int n = tid >> 3, kq = tid & 7;
        float f[8];
#pragma unroll
        for (int j = 0; j < 8; ++j) f[j] = tile[(8 * kq + j) * 65 + n];
        u32x4 w = {pk2(f[0], f[1]), pk2(f[2], f[3]), pk2(f[4], f[5]), pk2(f[6], f[7])};
        *(u32x4*)(dst + (size_t)(dst_row0 + n) * ldK + k0 + 8 * kq) = w;
    }
    __syncthreads();
}
__device__ __forceinline__ void conv_tile_f8(const float* __restrict__ src, int ldN, int k0, int n0, unsigned char* __restrict__ dst, int ldK, int dst_row0, float* tile) {
    const int tid = tid_();
    {
        const int r = tid >> 4, c4 = tid & 15;
#pragma unroll
        for (int i = 0; i < 2; ++i) {
            const int row = r + 32 * i;
            const f32x4 v = *(const f32x4*)(src + (size_t)(k0 + row) * ldN + n0 + 4 * c4);
            tile[row * 65 + 4 * c4 + 0] = v[0]; tile[row * 65 + 4 * c4 + 1] = v[1]; tile[row * 65 + 4 * c4 + 2] = v[2]; tile[row * 65 + 4 * c4 + 3] = v[3];
        }
    }
    __syncthreads();
    {
        const int n = tid >> 3, kq = tid & 7;
        float f[8];
#pragma unroll
        for (int j = 0; j < 8; ++j) f[j] = tile[(8 * kq + j) * 65 + n] * 32.0f;
        *(u32x2*)(dst + (size_t)(dst_row0 + n) * ldK + k0 + 8 * kq) = (u32x2){pk4_fp8(f[0], f[1], f[2], f[3]), pk4_fp8(f[4], f[5], f[6], f[7])};
    }
    __syncthreads();
}
constexpr int NT_WIN = 2048, NT_SQ = 768, NT_WF = 192, NT_WSD = 64, NT_EGU = 256 * 128, NT_ED = 256 * 64;
constexpr int NT_ALL = NT_WIN + NT_SQ + NT_WF + NT_WSD;
__device__ __forceinline__ void conv_job(const P& p, int idx, float* tile) {
    unsigned char* ws = p.ws;
    if (idx < NT_WIN) { const int nb = idx >> 4, kb = idx & 15; const int n0 = 64 * nb + (64 * nb >= 2048 ? 16 : 0);
        conv_tile_f8(p.w_in, 8208, 64 * kb, n0, ws + OFF_WINT, 1024, 64 * nb, tile); return; }
    idx -= NT_WIN;
    if (idx < NT_SQ) { const int mat = idx >> 8, rem = idx & 255, nb = rem >> 4, kb = rem & 15;
        const float* src = mat == 0 ? p.w_bg : (mat == 1 ? p.w_bd : p.w_out); unsigned char* dst = ws + (mat == 0 ? OFF_WBG : (mat == 1 ? OFF_WBD : OFF_WO));
        conv_tile_f8(src, 1024, 64 * kb, 64 * nb, dst, 1024, 64 * nb, tile); return; }
    idx -= NT_SQ;
    if (idx < NT_WF) { const int nbd = idx >> 4, kb = idx & 15; bf16_t* dst = (bf16_t*)(ws + OFF_WF);
        if (nbd < 4) { conv_tile(p.w_router, 256, 64 * kb, 64 * nbd, dst, 1024, 64 * nbd, tile); }
        else { const int q = nbd - 4, tl = q >> 2, part = q & 3; const float* src = part < 2 ? p.w_sg : p.w_su;
            conv_tile(src, 256, 64 * kb, 128 * tl + 64 * (part & 1), dst, 1024, 64 * nbd, tile); }
        return; }
    idx -= NT_WF;
    if (idx < NT_WSD) { const int nb = idx >> 2, kb = idx & 3; conv_tile(p.w_sd, 1024, 64 * kb, 64 * nb, (bf16_t*)(ws + OFF_WSD), 256, 64 * nb, tile); return; }
    idx -= NT_WSD;
    if (idx < NT_EGU) { const int e = idx >> 7, rem = idx & 127, nbd = rem >> 4, kb = rem & 15, tl = nbd >> 2, part = nbd & 3;
        const float* src = (part < 2 ? p.w_eg : p.w_eu) + (size_t)e * 1024 * 256;
        conv_tile(src, 256, 64 * kb, 128 * tl + 64 * (part & 1), (bf16_t*)(ws + OFF_WGU) + (size_t)e * 512 * 1024, 1024, 64 * nbd, tile); return; }
    idx -= NT_EGU;
    { const int e = idx >> 6, rem = idx & 63, nb = rem >> 2, kb = rem & 3;
        conv_tile(p.w_ed + (size_t)e * 256 * 1024, 1024, 64 * kb, 64 * nb, (bf16_t*)(ws + OFF_WD) + (size_t)e * 1024 * 256, 256, 64 * nb, tile); }
}
__device__ __forceinline__ void phase_p0(const P& p, unsigned char* smem, int bid, int G) {
    float* fs = (float*)smem;
    const int tid = tid_();
    for (int u = bid; u < 192; u += G) {
        for (int k = tid; k < 1024; k += NTHR) fs[k] = siluf_(p.c[k]);
        __syncthreads();
        const int kg = tid >> 5, col = tid & 31; float s = 0.f;
#pragma unroll 16
        for (int k = kg; k < 1024; k += 16) s += fs[k] * __builtin_nontemporal_load(p.w_ada + (size_t)k * 6144 + 32 * u + col);
        fs[1024 + tid] = s;
        __syncthreads();
        if (tid < 32) { float t = 0.f;
#pragma unroll
            for (int g = 0; g < 16; ++g) t += fs[1024 + 32 * g + tid];
            ((float*)(p.ws + OFF_MOD))[32 * u + tid] = t + p.b_ada[32 * u + tid]; }
        __syncthreads();
    }
    for (int i = bid * NTHR + tid; i < 16 * 1024; i += G * NTHR) { const int j = i >> 10, k = i & 1023; ((bf16_t*)(p.ws + OFF_WAT))[i] = (bf16_t)f2bf(p.w_in[(size_t)k * 8208 + 2048 + j]); }
}
__device__ __forceinline__ void phase_conv(const P& p, unsigned char* smem, int bid, int G, int j0, int j1) {
    __syncthreads();
    for (int t = j0 + bid; t < j1; t += G) conv_job(p, t, (float*)smem + 1536);
}

__device__ __forceinline__ void phase_norm(const float* __restrict__ x, const float* __restrict__ g, const float* __restrict__ sc, const float* __restrict__ sh, bf16_t* __restrict__ out, unsigned char* __restrict__ out8, int bid, int G) {
    const int tid = tid_(), wid = tid >> 6, lane = tid & 63;
    for (int row = bid * 8 + wid; row < T_; row += G * 8) {
        f32x4 v[4]; float ss = 0.f;
#pragma unroll
        for (int j = 0; j < 4; ++j) { v[j] = *(const f32x4*)(x + (size_t)row * D_ + 256 * j + 4 * lane); ss += v[j][0] * v[j][0] + v[j][1] * v[j][1] + v[j][2] * v[j][2] + v[j][3] * v[j][3]; }
        ss = wave_sum(ss);
        const float rstd = rsqrtf(ss * (1.0f / 1024.0f) + EPS);
#pragma unroll
        for (int j = 0; j < 4; ++j) { const int c = 256 * j + 4 * lane;
            const f32x4 gg = *(const f32x4*)(g + c), s1 = *(const f32x4*)(sc + c), s0 = *(const f32x4*)(sh + c);
            f32x4 y = v[j] * rstd * gg * (s1 + 1.0f) + s0;
            u32x2 w = {pk2(y[0], y[1]), pk2(y[2], y[3])};
            *(u32x2*)(out + (size_t)row * D_ + c) = w;
            if (out8) *(unsigned*)(out8 + (size_t)row * D_ + c) = pk4_fp8(y[0], y[1], y[2], y[3]); }
    }
}

constexpr float QSCALE = 0.125f * 1.4426950408889634f;
__device__ __forceinline__ float logsig(float z) { return fminf(z, 0.f) - __logf(1.0f + __expf(-fabsf(z))); }
__device__ __forceinline__ void prep_chunk(const P& p, int n, unsigned char* smem) {
    float* alow_s = (float*)smem;
    bf16_t* tt = (bf16_t*)(smem + 4096);
    const int tid = tid_(), wid = tid >> 6, lane = tid & 63;
    bf16_t* PROJ = (bf16_t*)(p.ws + OFF_PROJ); const bf16_t* H = (const bf16_t*)(p.ws + OFF_H); const bf16_t* WaT = (const bf16_t*)(p.ws + OFF_WAT);
    if (wid < 4) {
        const int fr = lane & 15, fq = lane >> 4; f32x4 acc = {0.f, 0.f, 0.f, 0.f};
        const bf16_t* ap = H + (size_t)(64 * n + 16 * wid + fr) * D_ + 8 * fq; const bf16_t* bp = WaT + (size_t)fr * D_ + 8 * fq;
#pragma unroll 1
        for (int k0 = 0; k0 < D_; k0 += 256) { bf16x8 av[8], bv[8];
#pragma unroll
            for (int j = 0; j < 8; ++j) { av[j] = *(const bf16x8*)(ap + k0 + 32 * j); bv[j] = *(const bf16x8*)(bp + k0 + 32 * j); }
#pragma unroll
            for (int j = 0; j < 8; ++j) acc = MFMA16(av[j], bv[j], acc); }
#pragma unroll
        for (int r = 0; r < 4; ++r) alow_s[(16 * wid + 4 * fq + r) * 16 + fr] = acc[r];
    }
    __syncthreads();
    {
        const int ch = tid; float w2[16];
#pragma unroll
        for (int j = 0; j < 16; ++j) w2[j] = p.gla_w_a2[j * 512 + ch];
        const float bb = p.gla_b_a[ch]; float suf = 0.f; bf16_t* dst = (bf16_t*)(p.ws + OFF_KDT) + ((size_t)n * 512 + ch) * 64;
#pragma unroll 1
        for (int c32 = 1; c32 >= 0; --c32) {
            unsigned short kraw[32];
#pragma unroll
            for (int i = 0; i < 32; ++i) kraw[i] = PROJ[(size_t)(64 * n + 32 * c32 + i) * NPROJ + C_GK + ch];
#pragma unroll
            for (int c8 = 3; c8 >= 0; --c8) { float kd[8];
#pragma unroll
                for (int i = 7; i >= 0; --i) { const int c = 32 * c32 + 8 * c8 + i; float z = bb;
#pragma unroll
                    for (int j = 0; j < 16; ++j) z += alow_s[c * 16 + j] * w2[j];
                    kd[i] = bf2f(kraw[8 * c8 + i]) * __expf(suf);
                    suf += logsig(z) * (1.0f / 16.0f); }
                u32x4 w = {pk2(kd[0], kd[1]), pk2(kd[2], kd[3]), pk2(kd[4], kd[5]), pk2(kd[6], kd[7])};
                *(u32x4*)(dst + 32 * c32 + 8 * c8) = w; }
        }
        ((float*)(p.ws + OFF_DEC))[n * 512 + ch] = __expf(suf);
    }
#pragma unroll 1
    for (int piece = 0; piece < 4; ++piece) {
        const int mat = piece >> 1, cb = (mat == 0 ? C_GV : C_DV) + 512 * (piece & 1);
        __syncthreads();
        { u32x4 v[8];
#pragma unroll
          for (int i = 0; i < 8; ++i) { const int pidx = tid + NTHR * i, c = pidx >> 6, q16 = pidx & 63; v[i] = *(const u32x4*)(PROJ + (size_t)(64 * n + c) * NPROJ + cb + 8 * q16); }
#pragma unroll
          for (int i = 0; i < 8; ++i) { const int pidx = tid + NTHR * i, c = pidx >> 6, q16 = pidx & 63; *(u32x4*)(tt + c * 520 + 8 * q16) = v[i]; } }
        __syncthreads();
        const int col = 512 * (piece & 1) + tid;
        if (mat == 0) {
            bf16_t* dst = (bf16_t*)(p.ws + OFF_VTG) + ((size_t)n * 1024 + col) * 64;
#pragma unroll
            for (int cq = 0; cq < 4; ++cq) { unsigned w[8];
#pragma unroll
                for (int j = 0; j < 8; ++j) w[j] = (unsigned)tt[(16 * cq + 2 * j) * 520 + tid] | ((unsigned)tt[(16 * cq + 2 * j + 1) * 520 + tid] << 16);
                *(u32x4*)(dst + 16 * cq) = (u32x4){w[0], w[1], w[2], w[3]}; *(u32x4*)(dst + 16 * cq + 8) = (u32x4){w[4], w[5], w[6], w[7]}; }
        } else {
            unsigned char* dst = p.ws + OFF_V8T + (size_t)col * T_ + 64 * n;
#pragma unroll
            for (int q = 0; q < 4; ++q) { unsigned w[4];
#pragma unroll
                for (int j = 0; j < 4; ++j) { float f[4];
#pragma unroll
                    for (int e = 0; e < 4; ++e) { const int g = 4 * j + e, key = 32 * (q & 1) + crow(g, q >> 1); f[e] = bf2f(tt[key * 520 + tid]); }
                    w[j] = pk4_fp8(f[0], f[1], f[2], f[3]); }
                *(u32x4*)(dst + 16 * q) = (u32x4){w[0], w[1], w[2], w[3]}; }
        }
    }
#pragma unroll 1
    for (int i0 = 0; i0 < 16; i0 += 4) {
        u32x4 ra[4], rb[4];
#pragma unroll
        for (int ii = 0; ii < 4; ++ii) { const int idx = wid * 16 + i0 + ii, which = idx >> 6, c = idx & 63;
            const bf16_t* base = PROJ + (size_t)(64 * n + c) * NPROJ + (which ? C_DK : C_DQ) + 16 * lane; ra[ii] = *(const u32x4*)base; rb[ii] = *(const u32x4*)(base + 8); }
#pragma unroll
        for (int ii = 0; ii < 4; ++ii) {
            const int idx = wid * 16 + i0 + ii, which = idx >> 6, c = idx & 63, t = 64 * n + c;
            const u32x4 a = ra[ii], b = rb[ii];
            float v[16];
#pragma unroll
            for (int j = 0; j < 4; ++j) { v[2 * j] = bflo(a[j]); v[2 * j + 1] = bfhi(a[j]); v[8 + 2 * j] = bflo(b[j]); v[8 + 2 * j + 1] = bfhi(b[j]); }
            float ss = 0.f;
#pragma unroll
            for (int j = 0; j < 16; ++j) ss += v[j] * v[j];
            ss += __shfl_xor(ss, 1); ss += __shfl_xor(ss, 2);
            const float rstd = rsqrtf(ss * (1.0f / 64.0f) + EPS);
            const float* g = (which ? p.kn_g : p.qn_g) + 16 * (lane & 3);
#pragma unroll
            for (int j = 0; j < 16; ++j) v[j] = v[j] * rstd * g[j];
            if ((lane & 3) == 0) {
                const float pos = (float)p.pos[t];
#pragma unroll
                for (int j = 0; j < 8; ++j) {
                    const float ang = pos * p.invf[j];
                    const double rev = (double)ang * 0.15915494309189535; const float fr = (float)(rev - floor(rev));
                    const float cs = __builtin_amdgcn_cosf(fr), sn = __builtin_amdgcn_sinf(fr);
                    const float t1 = v[j], t2 = v[8 + j]; v[j] = t1 * cs - t2 * sn; v[8 + j] = t2 * cs + t1 * sn; }
            }
            const float qs = which ? 1.0f : 1.4426950408889634f;
            u32x4 o8;
#pragma unroll
            for (int j = 0; j < 4; ++j) o8[j] = pk4_fp8(v[4 * j] * qs, v[4 * j + 1] * qs, v[4 * j + 2] * qs, v[4 * j + 3] * qs);
            *(u32x4*)(p.ws + (which ? OFF_K8 : OFF_Q8) + (size_t)t * D_ + 16 * lane) = o8;
        }
    }
}

template <bool FINAL>
__device__ __forceinline__ void gla_unit(const P& p, int s, int h, unsigned char* smem) {
    const int tid = tid_(), wid = tid >> 6, lane = tid & 63, r = lane & 31, hi = lane >> 5;
    const bf16_t* PROJ = (const bf16_t*)(p.ws + OFF_PROJ); const bf16_t* KDT = (const bf16_t*)(p.ws + OFF_KDT); const bf16_t* VTG = (const bf16_t*)(p.ws + OFF_VTG);
    const float* DEC = (const float*)(p.ws + OFF_DEC);
    float* o_s = (float*)(smem + 32768);
    LAS unsigned char* q_s = (LAS unsigned char*)smem;
    const int qrow_ = tid >> 3, qch_ = tid & 7;
    u32x4 qpre0 = {0u, 0u, 0u, 0u}, qpre1 = {0u, 0u, 0u, 0u};
    if (FINAL) { const bf16_t* qp_ = PROJ + (size_t)(64 * (4 * s) + qrow_) * NPROJ + C_GQ + h * 128 + 8 * qch_; qpre0 = *(const u32x4*)qp_; qpre1 = *(const u32x4*)(qp_ + 64); }
    f32x16 st[4];
    const size_t sbase = ((size_t)s * 4 + h) * 128 * 256;
    if (FINAL) { const bf16_t* CARRY = (const bf16_t*)(p.ws + OFF_CARRY) + sbase;
#pragma unroll
        for (int b = 0; b < 4; ++b)
#pragma unroll
            for (int g = 0; g < 16; ++g) st[b][g] = bf2f(CARRY[(size_t)(32 * b + crow(g, hi)) * 256 + 32 * wid + r]);
    } else {
#pragma unroll
        for (int b = 0; b < 4; ++b)
#pragma unroll
            for (int g = 0; g < 16; ++g) st[b][g] = 0.f;
    }
    bf16x8 vbN[4], kaN[4][4];
#pragma unroll
    for (int ks = 0; ks < 4; ++ks) { vbN[ks] = *(const bf16x8*)(VTG + ((size_t)(4 * s) * 1024 + h * 256 + 32 * wid + r) * 64 + 16 * ks + 8 * hi);
#pragma unroll
        for (int b = 0; b < 4; ++b) kaN[ks][b] = *(const bf16x8*)(KDT + ((size_t)(4 * s) * 512 + h * 128 + 32 * b + r) * 64 + 16 * ks + 8 * hi); }
#pragma unroll 1
    for (int cn = 0; cn < 4; ++cn) {
        const int n = 4 * s + cn;
        if (FINAL) {
            { LAS unsigned char* qd_ = q_s + qrow_ * 264 + 16 * qch_;
              *(LAS u32x2*)qd_ = (u32x2){qpre0[0], qpre0[1]}; *(LAS u32x2*)(qd_ + 8) = (u32x2){qpre0[2], qpre0[3]}; *(LAS u32x2*)(qd_ + 128) = (u32x2){qpre1[0], qpre1[1]}; *(LAS u32x2*)(qd_ + 136) = (u32x2){qpre1[2], qpre1[3]}; }
            if (cn < 3) { const bf16_t* qp_ = PROJ + (size_t)(64 * (n + 1) + qrow_) * NPROJ + C_GQ + h * 128 + 8 * qch_; qpre0 = *(const u32x4*)qp_; qpre1 = *(const u32x4*)(qp_ + 64); }
        }
#pragma unroll
        for (int b = 0; b < 4; ++b)
#pragma unroll
            for (int g4 = 0; g4 < 4; ++g4) { const f32x4 d = *(const f32x4*)(DEC + n * 512 + h * 128 + 32 * b + 8 * g4 + 4 * hi);
#pragma unroll
                for (int i = 0; i < 4; ++i) st[b][4 * g4 + i] *= d[i]; }
#pragma unroll
        for (int ks = 0; ks < 4; ++ks) {
#pragma unroll
            for (int b = 0; b < 4; ++b) st[b] = MFMA32(kaN[ks][b], vbN[ks], st[b]);
        }
        if (cn < 3) {
#pragma unroll
            for (int ks = 0; ks < 4; ++ks) { vbN[ks] = *(const bf16x8*)(VTG + ((size_t)(n + 1) * 1024 + h * 256 + 32 * wid + r) * 64 + 16 * ks + 8 * hi);
#pragma unroll
                for (int b = 0; b < 4; ++b) kaN[ks][b] = *(const bf16x8*)(KDT + ((size_t)(n + 1) * 512 + h * 128 + 32 * b + r) * 64 + 16 * ks + 8 * hi); }
        }
        if (FINAL) {
            f32x16 o[2];
#pragma unroll
            for (int tb = 0; tb < 2; ++tb)
#pragma unroll
                for (int g = 0; g < 16; ++g) o[tb][g] = 0.f;
            __syncthreads();
#pragma unroll
            for (int b = 0; b < 4; ++b)
#pragma unroll
                for (int s2 = 0; s2 < 2; ++s2) {
                    u32x4 sb = {pk2(st[b][8 * s2 + 0], st[b][8 * s2 + 1]), pk2(st[b][8 * s2 + 2], st[b][8 * s2 + 3]), pk2(st[b][8 * s2 + 4], st[b][8 * s2 + 5]), pk2(st[b][8 * s2 + 6], st[b][8 * s2 + 7])};
#pragma unroll
                    for (int tb = 0; tb < 2; ++tb) {
                        LAS const unsigned char* qp = q_s + (32 * tb + r) * 264 + 2 * (32 * b + 16 * s2 + 4 * hi);
                        const u32x2 q0 = *(LAS const u32x2*)qp, q1 = *(LAS const u32x2*)(qp + 16);
                        u32x4 qa = {q0[0], q0[1], q1[0], q1[1]};
                        o[tb] = MFMA32(__builtin_bit_cast(bf16x8, qa), __builtin_bit_cast(bf16x8, sb), o[tb]);
                    }
                }
            __syncthreads();
#pragma unroll
            for (int tb = 0; tb < 2; ++tb)
#pragma unroll
                for (int g = 0; g < 16; ++g) o_s[(32 * tb + crow(g, hi)) * 256 + 32 * wid + r] = o[tb][g] * 0.08838834764831845f;
            __syncthreads();
            bf16_t* OGLA = (bf16_t*)(p.ws + OFF_OGLA);
#pragma unroll
            for (int i = 0; i < 8; ++i) {
                const int c = 8 * wid + i; const size_t t = (size_t)64 * n + c;
                const f32x4 v = *(const f32x4*)(o_s + c * 256 + 4 * lane);
                float ss = wave_sum(v[0] * v[0] + v[1] * v[1] + v[2] * v[2] + v[3] * v[3]);
                const float rstd = rsqrtf(ss * (1.0f / 256.0f) + EPS);
                const f32x4 gn = *(const f32x4*)(p.gla_onorm_g + 4 * lane);
                const u32x2 gg = *(const u32x2*)(PROJ + t * NPROJ + C_GG + h * 256 + 4 * lane);
                const float y0 = v[0] * rstd * gn[0] * siluf_(bflo(gg[0])), y1 = v[1] * rstd * gn[1] * siluf_(bfhi(gg[0])), y2 = v[2] * rstd * gn[2] * siluf_(bflo(gg[1])), y3 = v[3] * rstd * gn[3] * siluf_(bfhi(gg[1]));
                *(unsigned*)((unsigned char*)OGLA + t * D_ + h * 256 + 4 * lane) = pk4_fp8(y0, y1, y2, y3);
            }
        }
    }
    if (!FINAL) { bf16_t* LOC = (bf16_t*)(p.ws + OFF_LOC) + sbase;
#pragma unroll
        for (int b = 0; b < 4; ++b)
#pragma unroll
            for (int g = 0; g < 16; ++g) LOC[(size_t)(32 * b + crow(g, hi)) * 256 + 32 * wid + r] = (bf16_t)f2bf(st[b][g]);
    }
}
__device__ __forceinline__ void phase_g2(const P& p, int bid, int G) {
    const bf16_t* LOC = (const bf16_t*)(p.ws + OFF_LOC); bf16_t* CARRY = (bf16_t*)(p.ws + OFF_CARRY); const float* DEC = (const float*)(p.ws + OFF_DEC);
    for (int e = bid * NTHR + tid_(); e < 131072; e += G * NTHR) {
        const int h = e >> 15, dk = (e >> 8) & 127; float carry = 0.f;
        const float* d0 = DEC + h * 128 + dk;
#pragma unroll 1
        for (int s0 = 0; s0 < 64; s0 += 16) {
            float lv[16], pd[16];
#pragma unroll
            for (int i = 0; i < 16; ++i) { const float* d = d0 + (4 * (s0 + i)) * 512; lv[i] = bf2f(LOC[(size_t)(s0 + i) * 131072 + e]); pd[i] = d[0] * d[512] * d[1024] * d[1536]; }
#pragma unroll
            for (int i = 0; i < 16; ++i) { CARRY[(size_t)(s0 + i) * 131072 + e] = (bf16_t)f2bf(carry); carry = lv[i] + pd[i] * carry; }
        }
    }
}

constexpr int ATT_STAGE = 32768;
typedef int i32x8a __attribute__((ext_vector_type(8)));
typedef int i32x4a __attribute__((ext_vector_type(4)));
typedef short s16x2a __attribute__((ext_vector_type(2)));
__device__ __forceinline__ int pk4_fp8_div(float a, float b, float c, float d, float scale) { s16x2a w = {0, 0}; w = __builtin_amdgcn_cvt_scalef32_pk_fp8_f32(w, a, b, scale, false); w = __builtin_amdgcn_cvt_scalef32_pk_fp8_f32(w, c, d, scale, true); return __builtin_bit_cast(int, w); }
__device__ __forceinline__ i32x8a cat16u(u32x4 lo, u32x4 hi) { return __builtin_shufflevector(__builtin_bit_cast(i32x4a, lo), __builtin_bit_cast(i32x4a, hi), 0, 1, 2, 3, 4, 5, 6, 7); }
template <int AV>
__device__ __forceinline__ void attn_unit(const P& p, int h, int qb, unsigned char* smem) {
    const int tid = tid_(), lane = tid & 63, r = lane & 31, hi = lane >> 5; const int wid = __builtin_amdgcn_readfirstlane(tid >> 6);
    const unsigned char* K8 = p.ws + OFF_K8 + h * 128; const unsigned char* V8T = p.ws + OFF_V8T + (size_t)h * 128 * T_;
    LAS unsigned char* lds = (LAS unsigned char*)smem;
    const int q0 = qb * 256 + wid * 32, qc = q0 >> 6, nt = 2 * qb + 2;
#define ATT_STAGE_TILE(kt, buf) do { const int t3_ = tid_(); const unsigned srow_ = (unsigned)(t3_ >> 3), sch_ = (unsigned)((t3_ & 7) ^ ((t3_ >> 4) & 7)); \
        _Pragma("unroll") for (int j_ = 0; j_ < 2; ++j_) { \
        __builtin_amdgcn_global_load_lds((const unsigned*)(K8 + ((size_t)(kt) * 128 + 64 * j_ + srow_) * D_ + 16 * sch_), (LAS unsigned*)(lds + (buf) * ATT_STAGE + (512 * j_ + 64 * wid) * 16), 16, 0, 0); \
        __builtin_amdgcn_global_load_lds((const unsigned*)(V8T + (size_t)(64 * j_ + srow_) * T_ + (size_t)(kt) * 128 + 16 * sch_), (LAS unsigned*)(lds + (buf) * ATT_STAGE + 16384 + (512 * j_ + 64 * wid) * 16), 16, 0, 0); } } while (0)
    const unsigned FX = (unsigned)r * 128u + ((unsigned)((2 * hi) ^ ((r >> 1) & 7)) << 4);
    ATT_STAGE_TILE(0, 0);
    LAS unsigned char* qbase = lds + 3 * ATT_STAGE + wid * 4096;
    { const unsigned char* qrow = p.ws + OFF_Q8 + (size_t)(q0 + r) * D_ + h * 128 + 32 * hi;
#pragma unroll
      for (int m = 0; m < 2; ++m) { *(LAS u32x4*)(qbase + (FX ^ (unsigned)(64 * m))) = *(const u32x4*)(qrow + 64 * m); *(LAS u32x4*)(qbase + (FX ^ (unsigned)(64 * m + 16))) = *(const u32x4*)(qrow + 64 * m + 16); } }
    float noff;
    { int z = 0; asm volatile("" : "+v"(z)); float gq = 0.f, gk = 0.f;
      for (int i = 0; i < 64; ++i) { gq = fmaxf(gq, fabsf(p.qn_g[i + z])); gk = fmaxf(gk, fabsf(p.kn_g[i + z])); }
      noff = exp2f(ceilf(8.0f * 1.4426950408889634f * gq * gk) - 8.0f); }
    f32x16 O[2][4]; f32x2v la0 = {0.f, 0.f}, la1 = {0.f, 0.f};
#pragma unroll
    for (int m = 0; m < 2; ++m)
#pragma unroll
        for (int d = 0; d < 4; ++d)
#pragma unroll
            for (int g = 0; g < 16; ++g) O[m][d][g] = 0.f;
    i32x8a p8[2];
#pragma unroll
    for (int m = 0; m < 2; ++m)
#pragma unroll
        for (int g = 0; g < 8; ++g) p8[m][g] = 0;
    const f32x16 zero16 = {0.f, 0.f, 0.f, 0.f, 0.f, 0.f, 0.f, 0.f, 0.f, 0.f, 0.f, 0.f, 0.f, 0.f, 0.f, 0.f};
#define ATT_KF(dst, kb_, m_) dst = cat16u(*(LAS const u32x4*)((kb_) + (FX ^ (unsigned)(64 * (m_)))), *(LAS const u32x4*)((kb_) + (FX ^ (unsigned)(64 * (m_) + 16))))
#define ATT_VF(dst, v0_, v1_, d_) dst = cat16u(*(LAS const u32x4*)((v0_) + 4096 * (d_)), *(LAS const u32x4*)((v1_) + 4096 * (d_)))
#define ATT_EXPG(SC, PM, PO, j_, SCL) do { if (AV == 1) { p8[1 - (PM)][(PO) + (j_)] = (int)(__float_as_uint(SC[4 * (j_)]) ^ __float_as_uint(SC[4 * (j_) + 1]) ^ __float_as_uint(SC[4 * (j_) + 2]) ^ __float_as_uint(SC[4 * (j_) + 3])); break; } \
        _Pragma("unroll") for (int g_ = 4 * (j_); g_ < 4 * (j_) + 4; ++g_) SC[g_] = __builtin_amdgcn_exp2f(SC[g_]); \
        int w_; asm("v_cvt_scalef32_pk_fp8_f32 %0, %1, %2, %3" : "=v"(w_) : "v"(SC[4 * (j_)]), "v"(SC[4 * (j_) + 1]), "v"(SCL)); \
        asm("v_cvt_scalef32_pk_fp8_f32 %0, %1, %2, %3 op_sel:[0,0,0,1]" : "+v"(w_) : "v"(SC[4 * (j_) + 2]), "v"(SC[4 * (j_) + 3]), "v"(SCL)); \
        p8[1 - (PM)][(PO) + (j_)] = w_; } while (0)
#define ATT_STEP(SC, SN, DO_S, PM, V0, V1, PD, PO, LA, NDO, NKB, NM, NQ, MV, SCL) do { \
        i32x8a va_, vb_; \
        ATT_VF(va_, V0, V1, PD); ATT_VF(vb_, V0, V1, (PD) + 1); \
        __builtin_amdgcn_sched_barrier(0); \
        ATT_EXPG(SC, PM, PO, 0, SCL); \
        if (DO_S) { SN = __builtin_amdgcn_mfma_scale_f32_32x32x64_f8f6f4(kfN, qN, zero16, 0, 0, 0, 0x7F7F7F7F, 0, 0x7C7C7C7C); asm volatile("" : "+v"(SN)); }     \
        __builtin_amdgcn_sched_group_barrier(0x400, 4, 0); __builtin_amdgcn_sched_group_barrier(0x008, 1, 0); \
        __builtin_amdgcn_sched_barrier(0); \
        ATT_EXPG(SC, PM, PO, 1, SCL); \
        O[PM][PD] = __builtin_amdgcn_mfma_scale_f32_32x32x64_f8f6f4(p8[PM], va_, O[PM][PD], 0, 0, 0, 0x7F7F7F7F, 0, 0x7F7F7F7F); \
        __builtin_amdgcn_sched_group_barrier(0x400, 4, 0); __builtin_amdgcn_sched_group_barrier(0x008, 1, 0); \
        __builtin_amdgcn_sched_barrier(0); \
        ATT_EXPG(SC, PM, PO, 2, SCL); \
        O[PM][(PD) + 1] = __builtin_amdgcn_mfma_scale_f32_32x32x64_f8f6f4(p8[PM], vb_, O[PM][(PD) + 1], 0, 0, 0, 0x7F7F7F7F, 0, 0x7F7F7F7F); \
        if (NDO) ATT_KF(kfN, NKB, NM); if (NQ) ATT_KF(qN, qbase, NM); \
        __builtin_amdgcn_sched_group_barrier(0x400, 4, 0); __builtin_amdgcn_sched_group_barrier(0x008, 1, 0); \
        __builtin_amdgcn_sched_barrier(0); \
        ATT_EXPG(SC, PM, PO, 3, SCL); \
        if (AV != 1) { _Pragma("unroll") for (int g_ = 0; g_ < 8; ++g_) LA = (f32x2v){SC[2 * g_], SC[2 * g_ + 1]} * (f32x2v){MV, MV} + LA; } \
        __builtin_amdgcn_sched_barrier(0); } while (0)
#define ATT_FLUSH(V0, V1) do { _Pragma("unroll") for (int d_ = 0; d_ < 4; ++d_) { i32x8a vf_; ATT_VF(vf_, V0, V1, d_); \
        O[1][d_] = __builtin_amdgcn_mfma_scale_f32_32x32x64_f8f6f4(p8[1], vf_, O[1][d_], 0, 0, 0, 0x7F7F7F7F, 0, 0x7F7F7F7F); } \
        __builtin_amdgcn_sched_barrier(0); } while (0)
    LAS const unsigned char* pv0 = lds + 16384 + FX; LAS const unsigned char* pv1 = lds + 16384 + (FX ^ 16u);
    asm volatile("s_waitcnt vmcnt(0)" ::: "memory"); __syncthreads();
    if (wid >= 4) __builtin_amdgcn_s_setprio(1);
    int st = 0, st1 = 1;
#pragma unroll 1
    for (int kt = 0; kt < nt; ++kt) {
        if (kt + 1 < nt) ATT_STAGE_TILE(kt + 1, st1);
        const int nch = qc - 2 * kt + 1;
        LAS const unsigned char* sb = lds + st * ATT_STAGE;
        {
            const float mv0 = nch >= 1 ? 1.f : 0.f, mv1 = nch >= 2 ? 1.f : 0.f, sc0 = nch >= 1 ? noff : 0x1p120f, sc1 = nch >= 2 ? noff : 0x1p120f;
            f32x16 SA, SB; i32x8a kfN, qN;
            ATT_KF(kfN, sb, 0); ATT_KF(qN, qbase, 0);
            SA = __builtin_amdgcn_mfma_scale_f32_32x32x64_f8f6f4(kfN, qN, zero16, 0, 0, 0, 0x7F7F7F7F, 0, 0x7C7C7C7C);
            __builtin_amdgcn_sched_barrier(0);
            ATT_KF(kfN, sb + 4096, 0);
            __builtin_amdgcn_sched_barrier(0);
            LAS const unsigned char* c0 = sb + 16384 + FX; LAS const unsigned char* c1 = sb + 16384 + (FX ^ 16u);
            ATT_STEP(SA, SB, true, 1, pv0, pv1, 0, 0, la0,  true, sb, 1, true, mv0, sc0);
            ATT_STEP(SB, SA, true, 1, pv0, pv1, 2, 4, la0,  true, sb + 4096, 1, false, mv0, sc0);
            ATT_STEP(SA, SB, true, 0, c0, c1, 0, 0, la1,    true, sb + 8192, 0, true, mv0, sc0);
            ATT_STEP(SB, SA, true, 0, c0, c1, 2, 4, la1,    true, sb + 12288, 0, false, mv0, sc0);
            pv0 = sb + 16384 + (FX ^ 64u); pv1 = sb + 16384 + (FX ^ 80u);
            ATT_STEP(SA, SB, true, 1, c0, c1, 0, 0, la0,    true, sb + 8192, 1, true, mv1, sc1);
            ATT_STEP(SB, SA, true, 1, c0, c1, 2, 4, la0,    true, sb + 12288, 1, false, mv1, sc1);
            ATT_STEP(SA, SB, true, 0, pv0, pv1, 0, 0, la1,  false, sb, 0, false, mv1, sc1);
            ATT_STEP(SB, SA, false, 0, pv0, pv1, 2, 4, la1, false, sb, 0, false, mv1, sc1);
        }
        asm volatile("s_waitcnt vmcnt(0)" ::: "memory"); __syncthreads();
        st = st1; st1 = st1 == 2 ? 0 : st1 + 1;
    }
    ATT_FLUSH(pv0, pv1);
    __syncthreads();
    __builtin_amdgcn_s_setprio(0);
    float l0 = la0[0] + la0[1], l1 = la1[0] + la1[1];
#undef ATT_KF
#undef ATT_VF
#undef ATT_EXPG
#undef ATT_STEP
#undef ATT_FLUSH
#undef ATT_STAGE_TILE
    {
        const int tid2 = tid_(), lane2 = tid2 & 63, r2 = lane2 & 31, hi2 = lane2 >> 5; const int wid2 = __builtin_amdgcn_readfirstlane(tid2 >> 6);
        const int q02 = qb * 256 + wid2 * 32;
        int z = 0; asm volatile("" : "+v"(z));
        float la = 0.f, lb = 0.f;
        for (int i = 0; i < 64; ++i) { la += p.lq1[i + z] * p.lk1[i + z]; lb += p.lq2[i + z] * p.lk2[i + z]; }
        const float lam = __expf(la) - __expf(lb) + 0.2f;
        l0 += __uint_as_float(__builtin_amdgcn_ds_bpermute((lane2 ^ 32) << 2, __float_as_uint(l0)));
        l1 += __uint_as_float(__builtin_amdgcn_ds_bpermute((lane2 ^ 32) << 2, __float_as_uint(l1)));
        float gq2 = 0.f, gk2 = 0.f;
        for (int i = 0; i < 64; ++i) { gq2 = fmaxf(gq2, fabsf(p.qn_g[i + z])); gk2 = fmaxf(gk2, fabsf(p.kn_g[i + z])); }
        const float unsc = exp2f(ceilf(8.0f * 1.4426950408889634f * gq2 * gk2) - 8.0f);
        const float i0 = unsc / l0, i1 = unsc * lam / l1;
        bf16_t* ODIFF = (bf16_t*)(p.ws + OFF_ODIFF);
        float sgv[4];
#pragma unroll
        for (int d = 0; d < 4; ++d) sgv[d] = p.subln_g[32 * d + r2 + z] * 0.8f;
#pragma unroll
        for (int g = 0; g < 16; ++g) {
            const int row = crow(g, hi2);
            const float a0 = __uint_as_float(__builtin_amdgcn_ds_bpermute(row << 2, __float_as_uint(i0))), a1 = __uint_as_float(__builtin_amdgcn_ds_bpermute(row << 2, __float_as_uint(i1)));
            float o[4], ss = 0.f;
#pragma unroll
            for (int d = 0; d < 4; ++d) { o[d] = O[0][d][g] * a0 - O[1][d][g] * a1; ss += o[d] * o[d]; }
#pragma unroll
            for (int of = 16; of >= 1; of >>= 1) ss += __uint_as_float(__builtin_amdgcn_ds_bpermute((lane2 ^ of) << 2, __float_as_uint(ss)));
            const float rstd = rsqrtf(ss * (1.0f / 128.0f) + EPS);
#pragma unroll
            for (int d = 0; d < 4; ++d) ((unsigned char*)ODIFF)[(size_t)(q02 + row) * D_ + h * 128 + 32 * d + r2] = (unsigned char)pk4_fp8(o[d] * rstd * sgv[d], 0.f, 0.f, 0.f);
        }
    }
}

template <int CTRL> __device__ __forceinline__ float dppf_(float x) { return __int_as_float(__builtin_amdgcn_update_dpp(0, __float_as_int(x), CTRL, 0xF, 0xF, false)); }
template <bool PROBE = false>
__device__ __forceinline__ void phase_route(const P& p, int bid, int G) {
    const int tid = tid_(), wid = tid >> 6, lane = tid & 63;
    const float* LOGITS = (const float*)(p.ws + OFF_LOGITS); int* cnt = (int*)(p.ws + OFF_CTL) + (PROBE ? 8192 : 0);
    int* EIDX = (int*)(p.ws + (PROBE ? OFF_PROJ + 40 * MiB : OFF_EIDX)); int* POSI = (int*)(p.ws + (PROBE ? OFF_PROJ + 41 * MiB : OFF_POSI)); int* TOKL = (int*)(p.ws + (PROBE ? OFF_PROJ : OFF_TOKL)); float* WL = (float*)(p.ws + (PROBE ? OFF_PROJ + 16 * MiB : OFF_WL));
    const f32x4 bias = *(const f32x4*)(p.router_bias + 4 * lane);
    int pt = -1, pE = 0, ppos = 0; float pw = 0.f;
    const int tstart = bid * 8 + wid, tstep = G * 8;
    f32x4 lgn = {0.f, 0.f, 0.f, 0.f};
    if (tstart < T_) lgn = *(const f32x4*)(LOGITS + (size_t)tstart * 256 + 4 * lane);
#pragma unroll 1
    for (int t = tstart; t < T_; t += tstep) {
        const f32x4 lg = lgn;
        if (t + tstep < T_) lgn = *(const f32x4*)(LOGITS + (size_t)(t + tstep) * 256 + 4 * lane);
        float sc[4], bv[4];
#pragma unroll
        for (int i = 0; i < 4; ++i) { sc[i] = sigmoidf_(lg[i]); bv[i] = sc[i] + bias[i]; }
        float m1 = fmaxf(bv[0], bv[1]), m2 = fminf(bv[0], bv[1]);
#pragma unroll
        for (int i = 2; i < 4; ++i) { const float a = bv[i]; m2 = fmaxf(m2, fminf(m1, a)); m1 = fmaxf(m1, a); }
        { float b1 = dppf_<0xB1>(m1), b2 = dppf_<0xB1>(m2); m2 = fmaxf(fminf(m1, b1), fmaxf(m2, b2)); m1 = fmaxf(m1, b1);
          b1 = dppf_<0x4E>(m1); b2 = dppf_<0x4E>(m2); m2 = fmaxf(fminf(m1, b1), fmaxf(m2, b2)); m1 = fmaxf(m1, b1);
          b1 = dppf_<0x141>(m1); b2 = dppf_<0x141>(m2); m2 = fmaxf(fminf(m1, b1), fmaxf(m2, b2)); m1 = fmaxf(m1, b1); }
        const float gs = m1 + m2; const int grp = lane >> 3; int rank = 0;
#pragma unroll
        for (int g2 = 0; g2 < 8; ++g2) { const float og = __int_as_float(__builtin_amdgcn_readlane(__float_as_int(gs), 8 * g2)); rank += (og > gs || (og == gs && g2 < grp)) ? 1 : 0; }
        const bool sel = rank < 4;
        float v[4];
#pragma unroll
        for (int i = 0; i < 4; ++i) v[i] = sel ? bv[i] : -INFINITY;
        int myE = 0; float myS = 0.f; float ssum = 0.f;
#pragma unroll
        for (int k = 0; k < 8; ++k) {
            float lm = v[0]; int li = 0;
#pragma unroll
            for (int i = 1; i < 4; ++i) if (v[i] > lm) { lm = v[i]; li = i; }
            float r = fmaxf(lm, dppf_<0xB1>(lm)); r = fmaxf(r, dppf_<0x4E>(r)); r = fmaxf(r, dppf_<0x141>(r)); r = fmaxf(r, dppf_<0x140>(r));
            const float r0 = __int_as_float(__builtin_amdgcn_readlane(__float_as_int(r), 0)), r1 = __int_as_float(__builtin_amdgcn_readlane(__float_as_int(r), 16));
            const float r2 = __int_as_float(__builtin_amdgcn_readlane(__float_as_int(r), 32)), r3 = __int_as_float(__builtin_amdgcn_readlane(__float_as_int(r), 48));
            const float gm = fmaxf(fmaxf(r0, r1), fmaxf(r2, r3));
            const unsigned long long bal = __builtin_amdgcn_ballot_w64(lm == gm);
            const int owner = (int)__builtin_ctzll(bal);
            const float ls = li == 0 ? sc[0] : (li == 1 ? sc[1] : (li == 2 ? sc[2] : sc[3]));
            const float sv = __int_as_float(__builtin_amdgcn_readlane(__float_as_int(ls), owner));
            const int wi = __builtin_amdgcn_readlane(li, owner);
            const int be = 4 * owner + wi;
            if (lane == owner) {
#pragma unroll
                for (int i = 0; i < 4; ++i) if (i == wi) v[i] = -INFINITY;
            }
            ssum += sv;
            if (lane == k) { myE = be; myS = sv; }
        }
        if (lane < 8 && pt >= 0) { const size_t li_ = (size_t)pE * T_ + (size_t)((pt >> 3) & 7) * (T_ / 8) + ppos; TOKL[li_] = pt; WL[li_] = pw; EIDX[pt * 8 + lane] = pE; POSI[pt * 8 + lane] = ppos; }
        pt = t; pE = myE; pw = myS / ssum * 2.5f;
        if (lane < 8) ppos = atomicAdd(cnt + myE * 8 + ((t >> 3) & 7), 1);
    }
    if (lane < 8 && pt >= 0) { const size_t li_ = (size_t)pE * T_ + (size_t)((pt >> 3) & 7) * (T_ / 8) + ppos; TOKL[li_] = pt; WL[li_] = pw; EIDX[pt * 8 + lane] = pE; POSI[pt * 8 + lane] = ppos; }
}

#define XB_TMO      128
#define XB_XCNT(j)  (256  + 64 * (j))
#define XB_XSUB(j)  (1280 + 64 * (j))
#define XB_XGEN(j)  (2304 + 64 * (j))
#define XB_TOP      3328
#define XB_TOPGEN   3392
#define XCD_BAR_WORDS 3456
#define XB_SPIN_CAP (1u << 18)

__device__ __forceinline__ unsigned xb_ld(unsigned* p)              { return __hip_atomic_load(p, __ATOMIC_RELAXED, __HIP_MEMORY_SCOPE_AGENT); }
__device__ __forceinline__ unsigned xb_add(unsigned* p, unsigned v) { return __hip_atomic_fetch_add(p, v, __ATOMIC_RELAXED, __HIP_MEMORY_SCOPE_AGENT); }
__device__ __forceinline__ unsigned xb_xcc_id() { return (unsigned)__builtin_amdgcn_s_getreg((3 << 11) | 20) & 0xFu; }
#define XB_SPIN(cond, bar) do { unsigned _sp = 0; while (cond) { __builtin_amdgcn_s_sleep(1); \
    if ((++_sp & 255u) == 0u) { if (xb_ld(&(bar)[XB_TMO])) break; if (_sp > XB_SPIN_CAP) { atomicAdd(&(bar)[XB_TMO], 1u); break; } } } } while (0)

struct XcdBarrier {
    unsigned* bar; unsigned x;
    volatile LAS unsigned* st;
};

__device__ __forceinline__ XcdBarrier xcd_barrier_post(unsigned* bar, volatile LAS unsigned* st) {
    XcdBarrier b; b.bar = bar; b.x = xb_xcc_id(); b.st = st;
    if (threadIdx.x == 0) (void)xb_add(&bar[XB_XCNT(b.x)], 1u);
    return b;
}
__device__ __forceinline__ void xcd_barrier_complete(unsigned* bar, unsigned x, unsigned& nloc, unsigned& nx) {
    const unsigned G = gridDim.x * gridDim.y * gridDim.z;
    unsigned sum, cnt, mine, sp = 0u;
    for (;;) {
        sum = 0u; cnt = 0u; mine = 0u;
#pragma unroll
        for (unsigned j = 0; j < 16; ++j) { const unsigned c = xb_ld(&bar[XB_XCNT(j)]); sum += c; cnt += (c > 0u) ? 1u : 0u; mine = (j == x) ? c : mine; }
        if (sum == G) break;
        __builtin_amdgcn_s_sleep(1);
        if ((++sp & 255u) == 0u) { if (xb_ld(&bar[XB_TMO])) break; if (sp > XB_SPIN_CAP) { atomicAdd(&bar[XB_TMO], 1u); break; } }
    }
    nloc = mine > 0u ? mine : 1u; nx = cnt > 0u ? cnt : 1u;
}

__device__ __forceinline__ void xcd_barrier(const XcdBarrier& b) {
    asm volatile("s_waitcnt vmcnt(0)" ::: "memory");
    __syncthreads();
    if (threadIdx.x == 0) {
        unsigned* bar = b.bar;
        __builtin_amdgcn_s_waitcnt(0);
        unsigned nloc = b.st[0], nx = b.st[1];
        if (nloc == 0u) { xcd_barrier_complete(bar, b.x, nloc, nx); b.st[0] = nloc; b.st[1] = nx; }
        const unsigned old = xb_add(&bar[XB_XSUB(b.x)], 1u);
        const unsigned gen = old / nloc;
        if (old + 1u == (gen + 1u) * nloc) {
            __builtin_amdgcn_fence(__ATOMIC_RELEASE, "agent");
            asm volatile("s_waitcnt vmcnt(0)" ::: "memory");
            const unsigned og = xb_add(&bar[XB_TOP], 1u);
            const unsigned tg = og / nx;
            if (og + 1u == (tg + 1u) * nx) xb_add(&bar[XB_TOPGEN], 1u);
            else XB_SPIN(xb_ld(&bar[XB_TOPGEN]) == tg, bar);
            __builtin_amdgcn_fence(__ATOMIC_ACQUIRE, "agent");
            xb_add(&bar[XB_XGEN(b.x)], 1u);
            asm volatile("s_waitcnt vmcnt(0)" ::: "memory");
        } else {
            XB_SPIN(xb_ld(&bar[XB_XGEN(b.x)]) == gen, bar);
            __builtin_amdgcn_fence(__ATOMIC_ACQUIRE, "agent");
            asm volatile("s_waitcnt vmcnt(0)" ::: "memory");
        }
    }
    __syncthreads();
}

constexpr size_t OFF_BAR = 16 << 10;
struct RowGather { const int* tokl; int pos0, cnt; __device__ __forceinline__ unsigned operator()(int r) const { int pos = pos0 + r; pos = pos < cnt ? pos : cnt - 1; return (unsigned)tokl[pos] * 1024u; } };
struct RowSlots { int base, pos0, cnt; __device__ __forceinline__ unsigned operator()(int r) const { int pos = pos0 + r; pos = pos < cnt ? pos : cnt - 1; return (unsigned)(base + pos) * 256u; } };

__device__ __forceinline__ void ph_norm1(const P& p, int bid, int G) { const float* mod = (const float*)(p.ws + OFF_MOD); phase_norm(p.x, p.norm1_g, mod + 1024, mod, (bf16_t*)(p.ws + OFF_H), p.ws + OFF_H2F8, bid, G); }
__device__ __forceinline__ void ph_inproj(const P& p, unsigned char* smem, int bid, int G) {
    EpiStoreBf16 E{(bf16_t*)(p.ws + OFF_PROJ), NPROJ};
    pg8::Gemm g{(const bf16_t*)(p.ws + OFF_H2F8), (const bf16_t*)(p.ws + OFF_WINT), T_, NPROJ, 512}; pg8::StaticOrder S; S.init(T_, NPROJ, G, bid);
    pg8::gemm_phase<EpiStoreBf16, pg8::StaticOrder, false, true, true>((PG8_LAS unsigned char*)smem, g, S, E);
}
__device__ __forceinline__ void ph_prep(const P& p, unsigned char* smem, int bid, int G) {
#pragma unroll 1
    for (int n = bid; n < 256; n += G) prep_chunk(p, n, smem);
}
template <bool FINAL> __device__ __forceinline__ void ph_gla(const P& p, unsigned char* smem, int bid, int G) {
#pragma unroll 1
    for (int u = bid; u < 256; u += G) gla_unit<FINAL>(p, u >> 2, u & 3, smem);
}
template <int AV>
__device__ __forceinline__ void ph_att(const P& p, unsigned char* smem, int bid, int G) {
#pragma unroll 1
    for (int uu = bid * 2; uu < 512; uu += (uu & 1) ? 2 * G - 1 : 1) { const int u = uu >> 1, h = u & 7, j = u >> 3; attn_unit<AV>(p, h, (uu & 1) ? 63 - j : j, smem); }
}
__device__ __forceinline__ void ph_b1(const P& p, unsigned char* smem, int bid, int G) {
    const bf16_t* PROJ = (const bf16_t*)(p.ws + OFF_PROJ);
    bf16_t* M1 = (bf16_t*)(p.ws + OFF_H);
    EpiB1a Ea{M1, PROJ}; EpiB1b Eb{M1, PROJ, (bf16_t*)(p.ws + OFF_MERGED)};
    pg8::StaticOrder S; S.init(T_, D_, G, bid);
    { pg8::Gemm g{(const bf16_t*)(p.ws + OFF_OGLA), (const bf16_t*)(p.ws + OFF_WBG), T_, D_, 512};
      pg8::gemm_phase<EpiB1a, pg8::StaticOrder, true, true, true>((PG8_LAS unsigned char*)smem, g, S, Ea); }
    __threadfence_block();
    { pg8::Gemm g{(const bf16_t*)(p.ws + OFF_ODIFF), (const bf16_t*)(p.ws + OFF_WBD), T_, D_, 512};
      pg8::gemm_phase<EpiB1b, pg8::StaticOrder, true, true, true>((PG8_LAS unsigned char*)smem, g, S, Eb); }
}
__device__ __forceinline__ void ph_b2(const P& p, unsigned char* smem, int bid, int G) {
    const float* mod = (const float*)(p.ws + OFF_MOD); EpiB2 E{p.x, mod + 2048, p.out};
    pg8::Gemm g{(const bf16_t*)(p.ws + OFF_MERGED), (const bf16_t*)(p.ws + OFF_WO), T_, D_, 512}; pg8::StaticOrder S; S.init(T_, D_, G, bid);
    pg8::gemm_phase<EpiB2, pg8::StaticOrder, true, true, true>((PG8_LAS unsigned char*)smem, g, S, E);
}
__device__ __forceinline__ void ph_norm2(const P& p, int bid, int G) { const float* mod = (const float*)(p.ws + OFF_MOD); phase_norm(p.out, p.norm2_g, mod + 4096, mod + 3072, (bf16_t*)(p.ws + OFF_H), p.ws + OFF_H2F8, bid, G); }
__device__ __forceinline__ void ph_f1(const P& p, unsigned char* smem, int bid, int G) {
    EpiF1 E{(float*)(p.ws + OFF_LOGITS), (bf16_t*)(p.ws + OFF_HS)};
    pg8::Gemm g{(const bf16_t*)(p.ws + OFF_H), (const bf16_t*)(p.ws + OFF_WF), T_, 768, 1024}; pg8::StaticOrder S; S.init(T_, 768, G, bid);
    pg8::gemm_phase<EpiF1, pg8::StaticOrder, true, true>((PG8_LAS unsigned char*)smem, g, S, E);
}
__device__ __forceinline__ void ph_route(const P& p, unsigned char* smem, int bid, int G) {
#ifndef RTP
#define RTP 0
#endif
    if (RTP) { phase_route<true>(p, bid, G); __syncthreads(); }
    phase_route<false>(p, bid, G);
    EpiStoreBf16 E{(bf16_t*)(p.ws + OFF_SD), D_};
    pg8::Gemm g{(const bf16_t*)(p.ws + OFF_HS), (const bf16_t*)(p.ws + OFF_WSD), T_, D_, 256}; pg8::StaticOrder S; S.init(T_, D_, G, bid);
#ifndef SDP
#define SDP 0
#endif
    pg8::gemm_phase<EpiStoreBf16, pg8::StaticOrder, true, true>((PG8_LAS unsigned char*)smem, g, S, E);
    if (SDP) { __syncthreads(); pg8::gemm_phase<EpiStoreBf16, pg8::StaticOrder, true, true>((PG8_LAS unsigned char*)smem, g, S, E); }
}
typedef short s16x4 __attribute__((ext_vector_type(4)));
__device__ __forceinline__ s16x4 ds_tr16(LAS const unsigned char* pp) { return __builtin_bit_cast(s16x4, __builtin_amdgcn_ds_read_tr16_b64_v4i16((LAS s16x4*)pp)); }
__device__ __forceinline__ void glds16_asm(const void* gsrc, unsigned lds_dst) { unsigned keep;
    asm volatile("s_mov_b32 %0, m0\n\ts_mov_b32 m0, %2\n\ts_nop 0\n\tglobal_load_lds_dwordx4 %1, off\n\ts_mov_b32 m0, %0" : "=&s"(keep) : "v"(gsrc), "s"(lds_dst) : "memory"); }
#ifndef MOE_NSL
#define MOE_NSL 2
#endif
constexpr int MOE_RING = 32768, MOE_BT = 3 * MOE_RING;
#ifndef XV
#define XV 0
#endif
__device__ __forceinline__ int list_idx(const int* so8, int r) { int sub = 0, off = 0; LAS const int* q8 = (LAS const int*)so8;
#pragma unroll
    for (int q = 1; q < 8; ++q) { const int o = q8[q]; if (r >= o) { sub = q; off = o; } }
    return sub * (T_ / 8) + (r - off); }
template <int MODE, int NA, int XVV = 0>
__device__ __forceinline__ void moe_pass(const P& p, unsigned char* smem, int e, int s, int cnt, int cstart, int row0, const int* so8) {
    constexpr int K = MODE == 0 ? 1024 : 256, NK = K / 64, BLD = MODE == 0 ? 256 : 1024;
    constexpr int NSL = MODE == 1 ? MOE_NSL : 1, NKT = NK * NSL;
    const int tid = tid_(), lane = tid & 63, fr = lane & 15, fq = lane >> 4; const int wid = __builtin_amdgcn_readfirstlane(tid >> 6);
    LAS unsigned char* lds = (LAS unsigned char*)smem; const unsigned lds0 = (unsigned)(uintptr_t)smem;
    const float* gsrc;
    { const int dk = tid >> 5, c4 = tid & 31;
      if (MODE == 0) gsrc = (c4 < 16 ? p.w_eg : p.w_eu) + (size_t)e * 1024 * 256 + (size_t)dk * 256 + 64 * s + 4 * (c4 & 15);
      else gsrc = p.w_ed + (size_t)e * 256 * 1024 + (size_t)dk * 1024 + 128 * (NSL * s) + 4 * c4; }
    constexpr int BLDX = XVV == 3 ? 0 : BLD; if (XVV == 3) gsrc = p.w_eg + 4 * (tid & 31);
    const int kr = tid >> 3, seg = tid & 7;
    const unsigned roff = (unsigned)kr * 512u + (unsigned)seg * 64u;
    unsigned woff[4];
    { const unsigned fk = (unsigned)((kr & 3) | (((kr >> 3) & 1) << 2)); const int gi = seg >> 1, hh = seg & 1;
#pragma unroll
      for (int q4 = 0; q4 < 4; ++q4) woff[q4] = (unsigned)MOE_BT + (unsigned)kr * 256u + ((((unsigned)(2 * gi + (q4 & 1))) ^ fk) << 5) + 8u * (unsigned)(2 * hh + (q4 >> 1)); }
    const int G4 = lane >> 4, q = (lane & 15) >> 2, pp = lane & 3;
    const unsigned LX = (unsigned)MOE_BT + (unsigned)(8 * G4 + q) * 256u + 8u * (unsigned)pp + ((unsigned)(q | ((G4 & 1) << 2)) << 5);
    const unsigned char* A = MODE == 0 ? (const unsigned char*)(p.ws + OFF_H2F8) : (const unsigned char*)(p.ws + OFF_HE);
    unsigned aoff[4];
    { const int* tokl = (const int*)(p.ws + OFF_TOKL) + (size_t)e * T_;
#pragma unroll
      for (int j = 0; j < 4; ++j) { int pos = row0 + 16 * (wid + 8 * j) + fr; pos = pos < cnt ? pos : cnt - 1;
          aoff[j] = MODE == 0 ? (unsigned)tokl[list_idx(so8, pos)] * 1024u + 8u * fq : (unsigned)(cstart + pos) * 256u + 8u * fq; } }
    constexpr int NA1 = NA > 0 ? NA : 1;
    f32x4 acc[NA1][8];
#pragma unroll
    for (int j = 0; j < NA1; ++j)
#pragma unroll
        for (int n = 0; n < 8; ++n) acc[j][n] = (f32x4){0.f, 0.f, 0.f, 0.f};
    u32x2 A0[NA1], A1[NA1];
#define MOE_DMA(t, slot) do { _Pragma("unroll") for (int j_ = 0; j_ < 4; ++j_) \
        glds16_asm(gsrc + (MODE == 1 ? (size_t)((t) >> 2) * 128 + ((size_t)((t) & 3) * 64 + 16 * j_) * BLDX : ((size_t)(t) * 64 + 16 * j_) * BLDX), (unsigned)__builtin_amdgcn_readfirstlane(lds0 + (unsigned)(slot) * MOE_RING + (512 * j_ + 64 * wid) * 16)); } while (0)
#define MOE_CONVERT(slot, bo) do { f32x4 br_[4]; _Pragma("unroll") for (int q4_ = 0; q4_ < 4; ++q4_) br_[q4_] = *(LAS const f32x4*)(lds + (slot) * MOE_RING + roff + 16 * q4_); \
        _Pragma("unroll") for (int q4_ = 0; q4_ < 4; ++q4_) { const u32x2 w_ = {pk2(br_[q4_][0], br_[q4_][1]), pk2(br_[q4_][2], br_[q4_][3])}; *(LAS u32x2*)(lds + (bo) + woff[q4_]) = w_; } } while (0)
#define MOE_LOADA0(AX, t, kk) do { if (NA > 0) { _Pragma("unroll") for (int j_ = 0; j_ < NA1; ++j_) { const unsigned vo_ = aoff[j_] + (unsigned)(MODE == 1 ? ((t) & 3) : (t)) * 64u; \
        asm volatile("s_nop 4\n\tglobal_load_dwordx2 %0, %1, %2 offset:%3" : "=v"(AX[j_]) : "v"(vo_), "s"(A), "i"(32 * (kk)) : "memory"); } } } while (0)
#define MOE_LOADA(AX, t, kk) do { if (NA > 0) { _Pragma("unroll") for (int j_ = 0; j_ < NA1; ++j_) { const unsigned vo_ = aoff[j_] + (unsigned)(MODE == 1 ? ((t) & 3) : (t)) * 64u; \
        asm volatile("s_nop 4\n\tglobal_load_dwordx2 %0, %1, %2 offset:%3" : "+v"(AX[j_]) : "v"(vo_), "s"(A), "i"(32 * (kk)) : "memory"); } } } while (0)
#define MOE_WAITA(AX, n) do { if (NA == 4) asm volatile("s_waitcnt vmcnt(%4)" : "+v"(AX[0]), "+v"(AX[NA1 > 1 ? 1 : 0]), "+v"(AX[NA1 > 2 ? 2 : 0]), "+v"(AX[NA1 > 3 ? 3 : 0]) : "i"(n) : "memory"); \
        else if (NA == 3) asm volatile("s_waitcnt vmcnt(%3)" : "+v"(AX[0]), "+v"(AX[NA1 > 1 ? 1 : 0]), "+v"(AX[NA1 > 2 ? 2 : 0]) : "i"(n) : "memory"); \
        else if (NA == 2) asm volatile("s_waitcnt vmcnt(%2)" : "+v"(AX[0]), "+v"(AX[NA1 > 1 ? 1 : 0]) : "i"(n) : "memory"); \
        else if (NA == 1) asm volatile("s_waitcnt vmcnt(%1)" : "+v"(AX[0]) : "i"(n) : "memory"); } while (0)
#define MOE_COMPUTE(AX, bo, kk) do { if (NA > 0) { bf16x8 aw_[NA1]; _Pragma("unroll") for (int j_ = 0; j_ < NA1; ++j_) aw_[j_] = fp8x8_to_bf16x8(AX[j_]); _Pragma("unroll") for (int n_ = 0; n_ < 8; ++n_) { \
        LAS const unsigned char* bp_ = lds + (bo) + (LX ^ (unsigned)(n_ << 5)) + (kk) * 8192; \
        const s16x4 t0_ = ds_tr16(bp_), t1_ = ds_tr16(bp_ + 1024); \
        const bf16x8 bf_ = {t0_[0], t0_[1], t0_[2], t0_[3], t1_[0], t1_[1], t1_[2], t1_[3]}; \
        _Pragma("unroll") for (int j_ = 0; j_ < NA1; ++j_) acc[j_][n_] = MFMA16(bf_, aw_[j_], acc[j_][n_]); } } } while (0)
#define MOE_BAR() __builtin_amdgcn_s_barrier()
    MOE_DMA(0, 0); MOE_DMA(1, 1);
    MOE_LOADA0(A0, 0, 0); MOE_LOADA0(A1, 0, 1);
    asm volatile("s_waitcnt vmcnt(0)" ::: "memory");
    MOE_BAR();
    MOE_CONVERT(0, 0);
    asm volatile("s_waitcnt lgkmcnt(0)" ::: "memory");
    MOE_BAR();
    int slot1 = 1, slot2 = 2;
#pragma unroll 1
    for (int sl = 0; sl < NSL; ++sl) {
#pragma unroll 1
    for (int tt = 0; tt < NK; ++tt) {
        const int t = sl * NK + tt;
        const unsigned bo = (unsigned)(t & 1) * 16384u;
        const int t1 = t + 1 < NKT ? t + 1 : NKT - 1, t2 = t + 2 < NKT ? t + 2 : NKT - 1;
        MOE_DMA(t2, slot2);
        MOE_WAITA(A0, NA + 4);
        MOE_COMPUTE(A0, bo, 0);
        MOE_WAITA(A1, 4);
        if (NA == 0) asm volatile("s_waitcnt vmcnt(4)" ::: "memory");
        MOE_BAR();
        MOE_LOADA(A0, t1, 0); MOE_CONVERT(slot1, bo ^ 16384u);
        MOE_COMPUTE(A1, bo, 1);
        MOE_LOADA(A1, t1, 1);
        asm volatile("s_waitcnt lgkmcnt(0)" ::: "memory");
        MOE_BAR();
        slot1 = slot2; slot2 = slot2 == 2 ? 0 : slot2 + 1;
    }
    MOE_WAITA(A0, 0); MOE_WAITA(A1, 0);
    if (NA == 0) asm volatile("s_waitcnt vmcnt(0)" ::: "memory");
    if (NA > 0) {
        const int tid2 = tid_(), fr2 = tid2 & 15, fq2 = (tid2 & 63) >> 4; const int wid2 = __builtin_amdgcn_readfirstlane(tid2 >> 6);
#pragma unroll
        for (int j = 0; j < NA1; ++j) {
            const int pos = row0 + 16 * (wid2 + 8 * j) + fr2;
            if (pos < cnt) {
                if (MODE == 0) {
                    unsigned char* orow = p.ws + OFF_HE + (size_t)(cstart + pos) * 256 + 64 * s + 8 * fq2;
#pragma unroll
                    for (int g = 0; g < 2; ++g) {
                        float h[8];
#pragma unroll
                        for (int b = 0; b < 2; ++b)
#pragma unroll
                            for (int i = 0; i < 4; ++i) h[4 * b + i] = siluf_(acc[j][2 * g + b][i]) * acc[j][4 + 2 * g + b][i];
                        *(u32x2*)(orow + 32 * g) = (u32x2){pk4_fp8(h[0], h[1], h[2], h[3]), pk4_fp8(h[4], h[5], h[6], h[7])};
                    }
                } else {
                    const float wt = ((const float*)(p.ws + OFF_WL))[(size_t)e * T_ + list_idx(so8, pos)];
                    unsigned char* orow = p.ws + OFF_YS + (size_t)(cstart + pos) * D_ + 128 * (NSL * s + sl) + 8 * fq2;
#pragma unroll
                    for (int g = 0; g < 4; ++g) {
                        const f32x4 v0 = acc[j][2 * g] * wt, v1 = acc[j][2 * g + 1] * wt;
                        *(u32x2*)(orow + 32 * g) = (u32x2){pk4_fp8(v0[0], v0[1], v0[2], v0[3]), pk4_fp8(v1[0], v1[1], v1[2], v1[3])};
                    }
                }
            }
        }
    }
    if (sl + 1 < NSL) {
#pragma unroll
        for (int j = 0; j < NA1; ++j)
#pragma unroll
            for (int n = 0; n < 8; ++n) acc[j][n] = (f32x4){0.f, 0.f, 0.f, 0.f};
    }
    }
#undef MOE_DMA
#undef MOE_CONVERT
#undef MOE_LOADA
#undef MOE_LOADA0
#undef MOE_WAITA
#undef MOE_COMPUTE
#undef MOE_BAR
}
template <int MODE, int XVV = 0>
__device__ __forceinline__ void moe_unit_pass(const P& p, int e, int s, int cnt, int cstart, int row0, unsigned char* smem, const int* so8) {
    const int wid = __builtin_amdgcn_readfirstlane(tid_() >> 6);
    const int nrows = (cnt - row0) < 512 ? (cnt - row0) : 512, ntile = (nrows + 15) >> 4;
    const int nact = ntile > wid ? (ntile - wid + 7) >> 3 : 0;
    if (nact == 4) moe_pass<MODE, 4, XVV>(p, smem, e, s, cnt, cstart, row0, so8);
    else if (nact == 3) moe_pass<MODE, 3, XVV>(p, smem, e, s, cnt, cstart, row0, so8);
    else if (nact == 2) moe_pass<MODE, 2, XVV>(p, smem, e, s, cnt, cstart, row0, so8);
    else if (nact == 1) moe_pass<MODE, 1, XVV>(p, smem, e, s, cnt, cstart, row0, so8);
    else moe_pass<MODE, 0, XVV>(p, smem, e, s, cnt, cstart, row0, so8);
}
template <int MODE, int XVV = 0>
__device__ __forceinline__ void ph_moe(const P& p, unsigned char* smem, int bid, int G) {
    int* cs = (int*)smem;
    const int* cnt = (const int*)(p.ws + OFF_CTL);
    __syncthreads();
    if (threadIdx.x < 256) { const int e = threadIdx.x; int a = 0;
#pragma unroll
        for (int q = 0; q < 8; ++q) { cs[1024 + 8 * e + q] = a; a += cnt[8 * e + q]; }
        cs[e] = a; }
    __syncthreads();
    if (threadIdx.x == 0) { int a = 0, mx = 0; for (int e = 0; e < 256; ++e) { const int c = cs[e]; cs[256 + e] = a; a += c; mx = c > mx ? c : mx; } cs[512] = mx; }
    __syncthreads();
    constexpr int NS = MODE == 0 ? 4 : 8 / MOE_NSL, NU1 = 256 * NS;
    const int NU = ((cs[512] + 511) >> 9) * NU1;
    unsigned* qctr = (unsigned*)(p.ws + OFF_CTL) + 2560 + MODE + (XVV ? 2 : 0);
    int u = bid;
#pragma unroll 1
    while (u < NU) {
        const int pass = u / NU1, r = u - pass * NU1;
        int e, s;
        if ((G & 63) == 0 && r < (NU1 / G) * G) { const int x = r & 7, y = (r >> 3) % (G >> 3), rnd = r / G; s = y % NS; e = rnd * (G / NS) + x * (G / (8 * NS)) + y / NS; }
        else { e = r / NS; s = r % NS; }
        const int c = cs[e], c0 = cs[256 + e];
        const bool pre = u + 2 * G < NU; int nxt = 0;
        if (pre && threadIdx.x == 0) nxt = G + (int)__hip_atomic_fetch_add(qctr, 1u, __ATOMIC_RELAXED, __HIP_MEMORY_SCOPE_AGENT);
        if (c > pass * 512) moe_unit_pass<MODE, XVV>(p, e, s, c, c0, pass * 512, smem + 12288, cs + 1024 + 8 * e);
        __syncthreads();
        if (threadIdx.x == 0) cs[513] = pre ? nxt : G + (int)__hip_atomic_fetch_add(qctr, 1u, __ATOMIC_RELAXED, __HIP_MEMORY_SCOPE_AGENT);
        __syncthreads();
        u = cs[513];
    }
}
template <bool PROBE = false>
__device__ __forceinline__ void ph_comb(const P& p, unsigned char* smem, int bid, int G) {
    int* cs = (int*)smem;
    const int* cnt = (const int*)(p.ws + OFF_CTL);
    __syncthreads();
    if (threadIdx.x < 256) { const int e = threadIdx.x; int a = 0;
#pragma unroll
        for (int q = 0; q < 8; ++q) { cs[256 + 8 * e + q] = a; a += cnt[8 * e + q]; }
        cs[e] = a; }
    __syncthreads();
    if (threadIdx.x == 0) { int a = 0; for (int e = 0; e < 256; ++e) { const int c = cs[e]; cs[e] = a; a += c; } }
    __syncthreads();
    if (threadIdx.x < 256) { const int e = threadIdx.x, c0 = cs[e];
#pragma unroll
        for (int q = 0; q < 8; ++q) cs[256 + 8 * e + q] += c0; }
    __syncthreads();
    const int tid = tid_(), wid = tid >> 6, lane = tid & 63;
    const float* gate = (const float*)(p.ws + OFF_MOD) + 5120; const bf16_t* SD = (const bf16_t*)(p.ws + OFF_SD); const unsigned char* YS = p.ws + OFF_YS;
    const int* EIDX = (const int*)(p.ws + OFF_EIDX); const int* POSI = (const int*)(p.ws + OFF_POSI);
    const int t0 = bid * 8 + wid, tstep = G * 8;
#pragma unroll 1
    for (int tb = t0; tb < T_; tb += 8 * tstep) {
        const int tl = tb + tstep * (lane >> 3);
        int slotv = 0;
        if (tl < T_) slotv = cs[256 + 8 * EIDX[tl * 8 + (lane & 7)] + ((tl >> 3) & 7)] + POSI[tl * 8 + (lane & 7)];
        u32x2 y[2][2][8]; u32x4 sd[2][2];
#define COMB_LOAD(i, b) do { const int t_ = tb + tstep * (i); if (t_ < T_) { _Pragma("unroll") for (int k_ = 0; k_ < 8; ++k_) { const int sl_ = __builtin_amdgcn_readlane(slotv, 8 * (i) + k_); \
            const unsigned char* yr_ = YS + (size_t)sl_ * D_ + 8 * lane; y[b][0][k_] = *(const u32x2*)yr_; y[b][1][k_] = *(const u32x2*)(yr_ + 512); } \
            sd[b][0] = *(const u32x4*)(SD + (size_t)t_ * D_ + 8 * lane); sd[b][1] = *(const u32x4*)(SD + (size_t)t_ * D_ + 512 + 8 * lane); } } while (0)
#define COMB_ACC(i, b) do { const int t_ = tb + tstep * (i); if (t_ < T_) { _Pragma("unroll") for (int j_ = 0; j_ < 2; ++j_) { const int c_ = 512 * j_ + 8 * lane; float a_[8]; \
            _Pragma("unroll") for (int q_ = 0; q_ < 4; ++q_) { a_[2 * q_] = bflo(sd[b][j_][q_]); a_[2 * q_ + 1] = bfhi(sd[b][j_][q_]); } \
            _Pragma("unroll") for (int k_ = 0; k_ < 8; ++k_) { _Pragma("unroll") for (int q_ = 0; q_ < 2; ++q_) { \
                const f32x2v lo_ = __builtin_amdgcn_cvt_pk_f32_fp8((int)y[b][j_][k_][q_], false), hi_ = __builtin_amdgcn_cvt_pk_f32_fp8((int)y[b][j_][k_][q_], true); \
                a_[4 * q_] += lo_[0]; a_[4 * q_ + 1] += lo_[1]; a_[4 * q_ + 2] += hi_[0]; a_[4 * q_ + 3] += hi_[1]; } } \
            float* o_ = p.out + (size_t)t_ * D_ + c_; float* w_ = PROBE ? (float*)(p.ws + OFF_OGLA) + (size_t)t_ * D_ + c_ : o_; \
            const f32x4 x0_ = *(const f32x4*)o_, x1_ = *(const f32x4*)(o_ + 4), g0_ = *(const f32x4*)(gate + c_), g1_ = *(const f32x4*)(gate + c_ + 4); \
            *(f32x4*)w_ = x0_ + g0_ * (f32x4){a_[0], a_[1], a_[2], a_[3]}; *(f32x4*)(w_ + 4) = x1_ + g1_ * (f32x4){a_[4], a_[5], a_[6], a_[7]}; } } } while (0)
        COMB_LOAD(0, 0);
#pragma unroll
        for (int i = 0; i < 8; i += 2) {
            COMB_LOAD(i + 1, 1); COMB_ACC(i, 0);
            if (i + 2 < 8) COMB_LOAD(i + 2, 0);
            COMB_ACC(i + 1, 1);
        }
#undef COMB_LOAD
#undef COMB_ACC
    }
}

extern __shared__ __attribute__((aligned(16))) unsigned char smem_dyn[];
#ifndef MK_FUSED
#define MK_FUSED 1
#endif
constexpr int LDS_BYTES = 142 * 1024;

#if MK_FUSED
__global__ void __launch_bounds__(NTHR, 2) k_fused(P p) {
    unsigned char* smem = smem_dyn + 64;
    if (threadIdx.x == 0) *(u32x4*)smem_dyn = (u32x4){0u, 0u, 0u, 0u};
    __syncthreads();
    XcdBarrier bar = xcd_barrier_post((unsigned*)(p.ws + OFF_BAR), (volatile LAS unsigned*)smem_dyn);
    const int bid = blockIdx.x, G = gridDim.x;
#ifndef DUP
#define DUP 0
#endif
#define RUN(bit, call) do { call; if (DUP & (1 << (bit))) { __syncthreads(); call; } } while (0)
    RUN(0, phase_p0(p, smem, bid, G));            xcd_barrier(bar);
    RUN(1, ph_norm1(p, bid, G)); phase_conv(p, smem, bid, G, 0, NT_WIN);                  xcd_barrier(bar);
    RUN(2, ph_inproj(p, smem, bid, G));           xcd_barrier(bar);
    RUN(11, ph_prep(p, smem, bid, G));            xcd_barrier(bar);
    RUN(8, ph_gla<false>(p, smem, bid, G));       xcd_barrier(bar);
    RUN(9, phase_g2(p, bid, G)); phase_conv(p, smem, bid, G, NT_WIN, NT_ALL);                  xcd_barrier(bar);
    RUN(10, ph_gla<true>(p, smem, bid, G));
#ifndef ATTP
#define ATTP 0
#endif
    if (ATTP) { ph_att<ATTP>(p, smem, bid, G); __syncthreads(); }
    RUN(4, ph_att<0>(p, smem, bid, G));           xcd_barrier(bar);
    RUN(5, ph_b1(p, smem, bid, G));               xcd_barrier(bar);
    RUN(5, ph_b2(p, smem, bid, G));               xcd_barrier(bar);
    RUN(1, ph_norm2(p, bid, G));                  xcd_barrier(bar);
    RUN(5, ph_f1(p, smem, bid, G));               xcd_barrier(bar);
    ph_route(p, smem, bid, G);                    xcd_barrier(bar);
#ifndef MOEP
#define MOEP 0
#endif
    if (MOEP & 1) { ph_moe<0, (XV ? XV : 4)>(p, smem, bid, G); __syncthreads(); }
    ph_moe<0>(p, smem, bid, G);                   xcd_barrier(bar);
    if (MOEP & 2) { ph_moe<1, (XV ? XV : 4)>(p, smem, bid, G); __syncthreads(); }
    ph_moe<1>(p, smem, bid, G);                   xcd_barrier(bar);
#ifndef CBP
#define CBP 0
#endif
    if (CBP) { ph_comb<true>(p, smem, bid, G); __syncthreads(); }
    ph_comb<false>(p, smem, bid, G);
}
#else
__global__ void __launch_bounds__(NTHR) k_p0(P p) { phase_p0(p, smem_dyn, blockIdx.x, gridDim.x); }
__global__ void __launch_bounds__(NTHR) k_norm1(P p) { ph_norm1(p, blockIdx.x, gridDim.x); phase_conv(p, smem_dyn, blockIdx.x, gridDim.x, 0, NT_WIN); }
__global__ void __launch_bounds__(NTHR) k_inproj(P p) { ph_inproj(p, smem_dyn, blockIdx.x, gridDim.x); }
__global__ void __launch_bounds__(NTHR) k_prep(P p) { ph_prep(p, smem_dyn, blockIdx.x, gridDim.x); }
__global__ void __launch_bounds__(NTHR) k_g1(P p) { ph_gla<false>(p, smem_dyn, blockIdx.x, gridDim.x); }
__global__ void __launch_bounds__(NTHR) k_g2(P p) { phase_g2(p, blockIdx.x, gridDim.x); phase_conv(p, smem_dyn, blockIdx.x, gridDim.x, NT_WIN, NT_ALL); }
__global__ void __launch_bounds__(NTHR) k_g3(P p) { ph_gla<true>(p, smem_dyn, blockIdx.x, gridDim.x); }
__global__ void __launch_bounds__(NTHR) k_att(P p) { ph_att<0>(p, smem_dyn, blockIdx.x, gridDim.x); }
__global__ void __launch_bounds__(NTHR) k_b1(P p) { ph_b1(p, smem_dyn, blockIdx.x, gridDim.x); }
__global__ void __launch_bounds__(NTHR) k_b2(P p) { ph_b2(p, smem_dyn, blockIdx.x, gridDim.x); }
__global__ void __launch_bounds__(NTHR) k_norm2(P p) { ph_norm2(p, blockIdx.x, gridDim.x); }
__global__ void __launch_bounds__(NTHR) k_f1(P p) { ph_f1(p, smem_dyn, blockIdx.x, gridDim.x); }
__global__ void __launch_bounds__(NTHR) k_route(P p) { ph_route(p, smem_dyn, blockIdx.x, gridDim.x); }
__global__ void __launch_bounds__(NTHR) k_m1(P p) { ph_moe<0>(p, smem_dyn, blockIdx.x, gridDim.x); }
__global__ void __launch_bounds__(NTHR) k_m2(P p) { ph_moe<1>(p, smem_dyn, blockIdx.x, gridDim.x); }
__global__ void __launch_bounds__(NTHR) k_comb(P p) { ph_comb<false>(p, smem_dyn, blockIdx.x, gridDim.x); }
#endif

extern "C" void kernel_launch(void* const* d_in, const int* in_sizes, int n_in, void* d_out, int out_size, void* d_ws, size_t ws_size, hipStream_t stream) {
    P p{};
    p.x = (const float*)d_in[0]; p.c = (const float*)d_in[1]; p.pos = (const int*)d_in[2]; p.w_ada = (const float*)d_in[3]; p.b_ada = (const float*)d_in[4]; p.norm1_g = (const float*)d_in[5];
    p.w_in = (const float*)d_in[6]; p.gla_w_a2 = (const float*)d_in[7]; p.gla_b_a = (const float*)d_in[8]; p.gla_onorm_g = (const float*)d_in[9]; p.qn_g = (const float*)d_in[10]; p.kn_g = (const float*)d_in[11];
    p.lq1 = (const float*)d_in[12]; p.lk1 = (const float*)d_in[13]; p.lq2 = (const float*)d_in[14]; p.lk2 = (const float*)d_in[15]; p.subln_g = (const float*)d_in[16];
    p.w_bg = (const float*)d_in[17]; p.w_bd = (const float*)d_in[18]; p.w_out = (const float*)d_in[19]; p.norm2_g = (const float*)d_in[20]; p.w_router = (const float*)d_in[21]; p.router_bias = (const float*)d_in[22];
    p.w_eg = (const float*)d_in[23]; p.w_eu = (const float*)d_in[24]; p.w_ed = (const float*)d_in[25]; p.w_sg = (const float*)d_in[26]; p.w_su = (const float*)d_in[27]; p.w_sd = (const float*)d_in[28];
    p.out = (float*)d_out; p.ws = (unsigned char*)d_ws;
    for (int i = 0; i < 8; ++i) p.invf[i] = (float)pow(500000.0, -(double)i / 8.0);
    (void)hipMemsetAsync(d_ws, 0, 64 << 10, stream);
#if MK_FUSED
    static int grid = 0;
    if (!grid) {
        int dev = 0, cus = 0, per_cu = 0;
        (void)hipGetDevice(&dev);
        (void)hipDeviceGetAttribute(&cus, hipDeviceAttributeMultiprocessorCount, dev);
        (void)hipFuncSetAttribute((const void*)k_fused, hipFuncAttributeMaxDynamicSharedMemorySize, LDS_BYTES);
        (void)hipOccupancyMaxActiveBlocksPerMultiprocessor(&per_cu, (const void*)k_fused, NTHR, LDS_BYTES);
        if (cus <= 0) cus = 256;
        grid = cus * (per_cu < 1 ? 1 : 1);
    }
    k_fused<<<grid, NTHR, LDS_BYTES, stream>>>(p);
#else
    static bool attr_done = false;
    if (!attr_done) { (void)hipFuncSetAttribute((const void*)k_g3, hipFuncAttributeMaxDynamicSharedMemorySize, 88 * 1024); attr_done = true; }
    const int G = 256;
    k_p0<<<G, NTHR, 32 * 1024, stream>>>(p);
    k_norm1<<<G, NTHR, 32 * 1024, stream>>>(p);
    k_inproj<<<G, NTHR, 0, stream>>>(p);
    k_prep<<<G, NTHR, 24 * 1024, stream>>>(p);
    k_g1<<<G, NTHR, 0, stream>>>(p);
    k_g2<<<G, NTHR, 32 * 1024, stream>>>(p);
    k_g3<<<G, NTHR, 88 * 1024, stream>>>(p);
    k_att<<<G, NTHR, 0, stream>>>(p);
    k_b1<<<G, NTHR, 0, stream>>>(p);
    k_b2<<<G, NTHR, 0, stream>>>(p);
    k_norm2<<<G, NTHR, 0, stream>>>(p);
    k_f1<<<G, NTHR, 0, stream>>>(p);
    k_route<<<G, NTHR, 0, stream>>>(p);
    k_m1<<<G, NTHR, 12288, stream>>>(p);
    k_m2<<<G, NTHR, 12288, stream>>>(p);
    k_comb<<<G, NTHR, 4096, stream>>>(p);
#endif
}
```

```cpp
#include <hip/hip_runtime.h>
#include <stdint.h>
#include <math.h>

#define LAS __attribute__((address_space(3)))
typedef unsigned short bf16_t;
typedef short bf16x8 __attribute__((ext_vector_type(8)));
typedef float f32x4 __attribute__((ext_vector_type(4)));
typedef float f32x16 __attribute__((ext_vector_type(16)));
typedef unsigned u32x4 __attribute__((ext_vector_type(4)));
typedef unsigned u32x2 __attribute__((ext_vector_type(2)));

constexpr int T_ = 16384, D_ = 1024, NPROJ = 8192, NTHR = 512;
constexpr size_t MiB = (size_t)1 << 20;
constexpr size_t OFF_CTL = 0, OFF_MOD = 64 << 10, OFF_WAT = 96 << 10, OFF_DEC = 128 << 10, OFF_EIDX = 1 * MiB, OFF_POSI = 1 * MiB + (512 << 10),
    OFF_WINT = 2 * MiB, OFF_WBG = 18 * MiB, OFF_WBD = 20 * MiB, OFF_WO = 22 * MiB, OFF_WF = 24 * MiB, OFF_WSD = 25 * MiB + (512 << 10), OFF_WGU = 26 * MiB,
    OFF_WD = 282 * MiB, OFF_PROJ = 410 * MiB, OFF_H = 666 * MiB, OFF_VT = 698 * MiB, OFF_VTG = 730 * MiB, OFF_KDT = 762 * MiB, OFF_LOC = 778 * MiB,
    OFF_CARRY = 810 * MiB, OFF_OGLA = 842 * MiB, OFF_ODIFF = 874 * MiB, OFF_MERGED = 906 * MiB,
    OFF_LOGITS = 698 * MiB, OFF_HS = 714 * MiB, OFF_SD = 722 * MiB, OFF_TOKL = 754 * MiB, OFF_WL = 770 * MiB, OFF_HE = 786 * MiB, OFF_YS = OFF_PROJ, OFF_H2F8 = 906 * MiB, OFF_Q8 = 26 * MiB, OFF_K8 = 42 * MiB, OFF_V8T = 58 * MiB;
constexpr int C_GQ = 0, C_GK = 512, C_GV = 1024, C_GG = 2048, C_DQ = 3072, C_DK = 4096, C_DV = 5120, C_MGL = 6144, C_MGD = 7168;
constexpr float EPS = 1e-6f;

struct P {
    const float *x, *c; const int* pos;
    const float *w_ada, *b_ada, *norm1_g, *w_in, *gla_w_a2, *gla_b_a, *gla_onorm_g, *qn_g, *kn_g, *lq1, *lk1, *lq2, *lk2, *subln_g, *w_bg, *w_bd, *w_out, *norm2_g,
        *w_router, *router_bias, *w_eg, *w_eu, *w_ed, *w_sg, *w_su, *w_sd;
    float* out; unsigned char* ws;
    float invf[8];
};

__device__ __forceinline__ unsigned f2bf(float f) { unsigned u = __float_as_uint(f); return (u + 0x7fffu + ((u >> 16) & 1u)) >> 16; }
__device__ __forceinline__ float bf2f(unsigned b) { return __uint_as_float(b << 16); }
typedef float f32x2_t __attribute__((ext_vector_type(2))); typedef __bf16 bf16x2_t __attribute__((ext_vector_type(2)));
__device__ __forceinline__ unsigned pk2(float lo, float hi) { const f32x2_t v = {lo, hi}; return __builtin_bit_cast(unsigned, __builtin_convertvector(v, bf16x2_t)); }
__device__ __forceinline__ float bflo(unsigned w) { return __uint_as_float(w << 16); }
__device__ __forceinline__ float bfhi(unsigned w) { return __uint_as_float(w & 0xffff0000u); }
__device__ __forceinline__ float sigmoidf_(float z) { return 1.0f / (1.0f + __expf(-z)); }
__device__ __forceinline__ float siluf_(float z) { return z / (1.0f + __expf(-z)); }
__device__ __forceinline__ float wave_sum(float v) {
#pragma unroll
    for (int o = 32; o >= 1; o >>= 1) v += __shfl_xor(v, o);
    return v;
}
__device__ __forceinline__ int tid_() { int t = threadIdx.x; asm volatile("" : "+v"(t)); return t; }
typedef float f32x2v __attribute__((ext_vector_type(2)));
__device__ __forceinline__ unsigned pk4_fp8(float a, float b, float c, float d) { int w = __builtin_amdgcn_cvt_pk_fp8_f32(a, b, 0, false); w = __builtin_amdgcn_cvt_pk_fp8_f32(c, d, w, true); return (unsigned)w; }
__device__ __forceinline__ bf16x8 fp8x8_to_bf16x8(u32x2 w) {
    const f32x2v a = __builtin_amdgcn_cvt_pk_f32_fp8((int)w[0], false), b = __builtin_amdgcn_cvt_pk_f32_fp8((int)w[0], true), c = __builtin_amdgcn_cvt_pk_f32_fp8((int)w[1], false), d = __builtin_amdgcn_cvt_pk_f32_fp8((int)w[1], true);
    const u32x4 r = {pk2(a[0], a[1]), pk2(b[0], b[1]), pk2(c[0], c[1]), pk2(d[0], d[1])}; return __builtin_bit_cast(bf16x8, r); }
#define MFMA16(a, b, c) __builtin_amdgcn_mfma_f32_16x16x32_bf16((a), (b), (c), 0, 0, 0)
#define MFMA32(a, b, c) __builtin_amdgcn_mfma_f32_32x32x16_bf16((a), (b), (c), 0, 0, 0)
__device__ __forceinline__ int crow(int reg, int hi) { return (reg & 3) + 8 * (reg >> 2) + 4 * hi; }

namespace pg8 {
#define PG8_LAS __attribute__((address_space(3)))
constexpr int BM = 256, BK = 64, HALF = 128, HTB = HALF * BK * 2  , STAGE_BYTES = 8 * HTB, NXCD = 8, WGM = 8;

__host__ __device__ __forceinline__ int lds_byte(int r, int c) { const int st = (r >> 4) * 2 + (c >> 5), rr = r & 15, cc = c & 31, ob = rr * 64 + cc * 2; return st * 1024 + (ob ^ (((ob >> 9) & 1) << 5)); }
__host__ __device__ __forceinline__ void stage_rc(int b, int& R, int& C) { const int st = b / 1024, sb = b % 1024, swz = sb ^ (((sb >> 9) & 1) << 5); R = (st >> 1) * 16 + swz / 64; C = (st & 1) * 32 + (swz % 64) / 2; }
__host__ __device__ __forceinline__ int perm32(int rho) { const int n = rho >> 4, i = rho & 15; return 8 * (i >> 2) + 4 * n + (i & 3); }
struct Unit { int pm, pn; };
struct Gemm { const bf16_t* A; const bf16_t* Bt; int M, N, K; };

struct StaticOrder {
    int nM, nN, nwg, G, c;
    __host__ __device__ void init(int M, int N, int G_, int c_) { nM = M / BM; nN = N / BM; nwg = nM * nN; G = G_; c = c_; }
    __host__ __device__ bool next(int i, Unit& u) const {
        const long L = (long)i * G + c; if (L >= nwg) return false;
        int wgid = (int)L; { const int q = nwg / NXCD, r = nwg % NXCD, xcd = wgid % NXCD, off = wgid / NXCD; wgid = (xcd < r ? xcd * (q + 1) : r * (q + 1) + (xcd - r) * q) + off; }
        const int nig = WGM * nN, gid = wgid / nig, fm = gid * WGM, gsz = (nM - fm) < WGM ? (nM - fm) : WGM;
        u.pm = fm + ((wgid % nig) % gsz); u.pn = (wgid % nig) / gsz; return true;
    }
    __device__ __forceinline__ void a_ready(const Unit&) const {}
    __device__ __forceinline__ void done(const Unit&) const {}
};
__device__ __forceinline__ void glds16_s(unsigned voff, const void* sbase, unsigned lds_dst) { unsigned keep;
    asm volatile("s_nop 4\n\ts_mov_b32 %0, m0\n\ts_mov_b32 m0, %3\n\ts_nop 0\n\tglobal_load_lds_dwordx4 %1, %2\n\ts_mov_b32 m0, %0" : "=&s"(keep) : "v"(voff), "s"(sbase), "s"(lds_dst) : "memory"); }
typedef int i32x8 __attribute__((ext_vector_type(8)));
typedef int i32x4 __attribute__((ext_vector_type(4)));
__device__ __forceinline__ i32x8 cat16(bf16x8 lo, bf16x8 hi) { return __builtin_shufflevector(__builtin_bit_cast(i32x4, lo), __builtin_bit_cast(i32x4, hi), 0, 1, 2, 3, 4, 5, 6, 7); }
template <class Epi, class Sched, bool ALIGN_EPI = false, bool SP2 = false, bool F8 = false>
__device__ __forceinline__ void gemm_phase(PG8_LAS unsigned char* lds, const Gemm g, const Sched& S, const Epi& E) {
    const int tid = tid_(), wid = __builtin_amdgcn_readfirstlane(tid >> 6), lane = tid & 63, wr = wid >> 2, wc = wid & 3, fr = lane & 15, fq = lane >> 4;
    const int K = g.K, nt = K / BK;
    unsigned voffA[2], voffB[2];
#pragma unroll
    for (int i = 0; i < 2; ++i) { int R, C; stage_rc(tid * 16 + i * 8192, R, C); const int Rb = Epi::PERM ? ((R & ~31) + perm32(R & 31)) : R;
        voffA[i] = (unsigned)(R * K + C) * 2u; voffB[i] = (unsigned)(Rb * K + C) * 2u; }
    const size_t kstep = (size_t)(BK * 2);
    const size_t hstep = (size_t)HALF * K * 2;
    const size_t tstep = 2 * hstep;
    const unsigned ldsw = (unsigned)wid * 1024u;
    const unsigned ldsb0 = (unsigned)(uintptr_t)lds;
    const int aoff = lds_byte(wr * 64 + fr, fq * 8), boff = lds_byte(wc * 32 + fr, fq * 8);
#define PG8_SA(b, h) (((b) * 2 + (h)) * HTB)
#define PG8_SB(b, h) ((4 + (b) * 2 + (h)) * HTB)
#define PG8_STAGE(bufoff, gbase, voff) do { _Pragma("unroll") for (int _i = 0; _i < 2; ++_i) { \
        if constexpr (F8) { int R_, C_; stage_rc((tid_() & 511) * 16 + _i * 8192, R_, C_); const bool isB_ = &(voff)[0] == &voffB[0]; if (isB_ && Epi::PERM) R_ = (R_ & ~31) + perm32(R_ & 31); \
            glds16_s((unsigned)(R_ * K + C_) * 2u, (const void*)(gbase), (unsigned)__builtin_amdgcn_readfirstlane(ldsb0 + (unsigned)(bufoff) + ldsw + _i * 8192)); } \
        else __builtin_amdgcn_global_load_lds((const unsigned*)((const char*)(gbase) + (voff)[_i]), (PG8_LAS unsigned*)(lds + (bufoff) + ldsw + _i * 8192), 16, 0, 0); } } while (0)
#define PG8_LDA(dst, b, h) do { _Pragma("unroll") for (int m = 0; m < 4; ++m) { if constexpr (F8) dst##8[m] = cat16(*(const PG8_LAS bf16x8*)(lds + PG8_SA(b, h) + aoff + m * 2048), *(const PG8_LAS bf16x8*)(lds + PG8_SA(b, h) + aoff + m * 2048 + 1024)); \
        else { _Pragma("unroll") for (int k = 0; k < 2; ++k) dst[m][k] = *(const PG8_LAS bf16x8*)(lds + PG8_SA(b, h) + aoff + m * 2048 + k * 1024); } } } while (0)
#define PG8_LDB(dst, b, h) do { _Pragma("unroll") for (int n = 0; n < 2; ++n) { if constexpr (F8) dst##8[n] = cat16(*(const PG8_LAS bf16x8*)(lds + PG8_SB(b, h) + boff + n * 2048), *(const PG8_LAS bf16x8*)(lds + PG8_SB(b, h) + boff + n * 2048 + 1024)); \
        else { _Pragma("unroll") for (int k = 0; k < 2; ++k) dst[n][k] = *(const PG8_LAS bf16x8*)(lds + PG8_SB(b, h) + boff + n * 2048 + k * 1024); } } } while (0)
#define PG8_MMA(ai, bj, At, Bt) do { __builtin_amdgcn_s_setprio(1); if constexpr (F8) { _Pragma("unroll") for (int m = 0; m < 4; ++m) _Pragma("unroll") for (int n = 0; n < 2; ++n) \
        acc[ai][bj][m][n] = __builtin_amdgcn_mfma_scale_f32_16x16x128_f8f6f4(Bt##8[n], At##8[m], acc[ai][bj][m][n], 0, 0, 0, 0x7A7A7A7A, 0, 0x7F7F7F7F); } else { \
        _Pragma("unroll") for (int m = 0; m < 4; ++m) _Pragma("unroll") for (int n = 0; n < 2; ++n) _Pragma("unroll") for (int k = 0; k < 2; ++k) \
        acc[ai][bj][m][n] = __builtin_amdgcn_mfma_f32_16x16x32_bf16(Bt[n][k], At[m][k], acc[ai][bj][m][n], 0, 0, 0); } __builtin_amdgcn_s_setprio(0); } while (0)
#define PG8_WAIT_V(n) asm volatile("s_waitcnt vmcnt(" #n ")" ::: "memory")
#define PG8_WAIT_L(n) asm volatile("s_waitcnt lgkmcnt(" #n ")" ::: "memory")
#define PG8_BAR __builtin_amdgcn_s_barrier()
#define PG8_SCHED __builtin_amdgcn_sched_barrier(0)
    Unit cur, nxt; int ui = 0;
    if (!S.next(0, cur)) return;
    f32x4 acc[2][2][4][2];
#pragma unroll
    for (int a = 0; a < 2; ++a)
#pragma unroll
        for (int b = 0; b < 2; ++b)
#pragma unroll
            for (int m = 0; m < 4; ++m)
#pragma unroll
                for (int n = 0; n < 2; ++n) acc[a][b][m][n] = (f32x4){0.f, 0.f, 0.f, 0.f};
    bf16x8 At[4][2], B0[2][2], B1[2][2]; i32x8 At8[4], B08[2], B18[2];
    const char* cA = (const char*)g.A + (size_t)cur.pm * tstep; const char* cB = (const char*)g.Bt + (size_t)cur.pn * tstep;
    S.a_ready(cur);
    if constexpr (SP2) {
        PG8_STAGE(PG8_SB(0, 0), cB, voffB); PG8_STAGE(PG8_SB(0, 1), cB + hstep, voffB); PG8_STAGE(PG8_SA(0, 0), cA, voffA); PG8_STAGE(PG8_SA(0, 1), cA + hstep, voffA);
        if (wr == 1) PG8_BAR;
        PG8_WAIT_V(2); PG8_BAR;
        PG8_STAGE(PG8_SB(1, 0), cB + kstep, voffB); PG8_STAGE(PG8_SA(1, 0), cA + kstep, voffA); PG8_STAGE(PG8_SB(1, 1), cB + hstep + kstep, voffB);
        PG8_WAIT_V(6); PG8_BAR;
    } else {
        PG8_STAGE(PG8_SB(0, 0), cB, voffB); PG8_STAGE(PG8_SA(0, 0), cA, voffA); PG8_STAGE(PG8_SB(0, 1), cB + hstep, voffB); PG8_STAGE(PG8_SA(0, 1), cA + hstep, voffA);
        if (wr == 1) PG8_BAR;
        PG8_WAIT_V(4); PG8_BAR;
        PG8_STAGE(PG8_SB(1, 0), cB + kstep, voffB); PG8_STAGE(PG8_SA(1, 0), cA + kstep, voffA); PG8_STAGE(PG8_SB(1, 1), cB + hstep + kstep, voffB);
        PG8_WAIT_V(6); PG8_BAR;
    }
    for (;;) {
        const bool has_next = S.next(ui + 1, nxt);
        const char* nA = has_next ? (const char*)g.A + (size_t)nxt.pm * tstep : cA; const char* nB = has_next ? (const char*)g.Bt + (size_t)nxt.pn * tstep : cB;
#pragma unroll 1
        for (int t = 0; t < nt; t += 2) {
            const bool last = (t == nt - 2);
            const char* a1 = cA + (size_t)(t + 1) * kstep;
            const char* a2 = last ? nA : cA + (size_t)(t + 2) * kstep; const char* b2 = last ? nB : cB + (size_t)(t + 2) * kstep;
            const char* a3 = a2 + kstep; const char* b3 = b2 + kstep;
            if (last && has_next) S.a_ready(nxt);
            if constexpr (SP2) {
            PG8_LDB(B0, 0, 0); PG8_LDB(B1, 0, 1); PG8_SCHED; PG8_LDA(At, 0, 0); PG8_STAGE(PG8_SA(1, 1), a1 + hstep, voffA);
            PG8_WAIT_V(8); PG8_WAIT_L(0); PG8_BAR; PG8_MMA(0, 0, At, B0); PG8_MMA(0, 1, At, B1); PG8_BAR; PG8_SCHED;
            PG8_LDA(At, 0, 1); PG8_STAGE(PG8_SB(0, 0), b2, voffB); PG8_STAGE(PG8_SB(0, 1), b2 + hstep, voffB); PG8_STAGE(PG8_SA(0, 0), a2, voffA);
            PG8_WAIT_V(8); PG8_WAIT_L(0); PG8_BAR; PG8_MMA(1, 0, At, B0); PG8_MMA(1, 1, At, B1); PG8_BAR; PG8_SCHED;
            PG8_LDB(B0, 1, 0); PG8_LDB(B1, 1, 1); PG8_SCHED; PG8_LDA(At, 1, 0); PG8_STAGE(PG8_SA(0, 1), a2 + hstep, voffA);
            PG8_WAIT_V(8); PG8_WAIT_L(0); PG8_BAR; PG8_MMA(0, 0, At, B0); PG8_MMA(0, 1, At, B1); PG8_BAR; PG8_SCHED;
            PG8_LDA(At, 1, 1); PG8_STAGE(PG8_SB(1, 0), b3, voffB); PG8_STAGE(PG8_SB(1, 1), b3 + hstep, voffB); PG8_STAGE(PG8_SA(1, 0), a3, voffA);
            PG8_WAIT_V(8); PG8_WAIT_L(0); PG8_BAR; PG8_MMA(1, 0, At, B0); PG8_MMA(1, 1, At, B1); PG8_BAR; PG8_SCHED;
            } else {
            PG8_LDB(B0, 0, 0); PG8_SCHED; PG8_LDA(At, 0, 0); PG8_STAGE(PG8_SA(1, 1), a1 + hstep, voffA);
            PG8_WAIT_L(8); PG8_BAR; PG8_WAIT_L(0); PG8_MMA(0, 0, At, B0); PG8_BAR; PG8_SCHED;
            PG8_LDB(B1, 0, 1); PG8_STAGE(PG8_SB(0, 0), b2, voffB);
            PG8_BAR; PG8_WAIT_L(0); PG8_MMA(0, 1, At, B1); PG8_BAR;
            PG8_LDA(At, 0, 1); PG8_STAGE(PG8_SA(0, 0), a2, voffA);
            PG8_BAR; PG8_WAIT_L(0); PG8_MMA(1, 0, At, B0); PG8_BAR; PG8_SCHED;
            PG8_STAGE(PG8_SB(0, 1), b2 + hstep, voffB);
            PG8_WAIT_V(6); PG8_BAR; PG8_MMA(1, 1, At, B1); PG8_BAR;
            PG8_LDB(B0, 1, 0); PG8_SCHED; PG8_LDA(At, 1, 0); PG8_STAGE(PG8_SA(0, 1), a2 + hstep, voffA);
            PG8_WAIT_L(8); PG8_BAR; PG8_WAIT_L(0); PG8_MMA(0, 0, At, B0); PG8_BAR; PG8_SCHED;
            PG8_LDB(B1, 1, 1); PG8_STAGE(PG8_SB(1, 0), b3, voffB);
            PG8_BAR; PG8_WAIT_L(0); PG8_MMA(0, 1, At, B1); PG8_BAR;
            PG8_LDA(At, 1, 1); PG8_STAGE(PG8_SA(1, 0), a3, voffA);
            PG8_BAR; PG8_WAIT_L(0); PG8_MMA(1, 0, At, B0); PG8_BAR; PG8_SCHED;
            PG8_STAGE(PG8_SB(1, 1), b3 + hstep, voffB);
            PG8_WAIT_V(6); PG8_BAR; PG8_MMA(1, 1, At, B1); PG8_BAR;
            }
        }
        if constexpr (ALIGN_EPI) { if (wr == 0) PG8_BAR; }
        if constexpr (!Epi::AFTER_DRAIN) { const int te_ = tid_() & 63; E(acc, cur, wr, wc, te_ & 15, te_ >> 4); S.done(cur); }
        if (!has_next) break;
#pragma unroll
        for (int a = 0; a < 2; ++a)
#pragma unroll
            for (int b = 0; b < 2; ++b)
#pragma unroll
                for (int m = 0; m < 4; ++m)
#pragma unroll
                    for (int n = 0; n < 2; ++n) acc[a][b][m][n] = (f32x4){0.f, 0.f, 0.f, 0.f};
        cur = nxt; cA = nA; cB = nB; ++ui;
        if constexpr (ALIGN_EPI) { if (wr == 1) PG8_BAR; }
    }
    PG8_WAIT_V(0);
    if constexpr (!ALIGN_EPI) { if (wr == 0) PG8_BAR; }
    PG8_BAR;
    if constexpr (Epi::AFTER_DRAIN) { E.fused(acc, cur, wr, wc, fr, fq, lds, wid, lane); S.done(cur); }
#undef PG8_SA
#undef PG8_SB
#undef PG8_STAGE
#undef PG8_LDA
#undef PG8_LDB
#undef PG8_MMA
#undef PG8_WAIT_V
#undef PG8_WAIT_L
#undef PG8_BAR
#undef PG8_SCHED
}
}
using pg8::Unit; using pg8::perm32;

template <class ARow, class Epi>
__device__ __forceinline__ void gemm_unit_direct(const bf16_t* __restrict__ A, const ARow& arow, const bf16_t* __restrict__ Btile, int K, const Epi& E, const Unit& u) {
    const int tid = tid_(), wid = tid >> 6, lane = tid & 63, wr = wid >> 2, wc = wid & 3, fr = lane & 15, fq = lane >> 4;
    f32x4 acc[2][2][4][2];
#pragma unroll
    for (int a = 0; a < 2; ++a)
#pragma unroll
        for (int b = 0; b < 2; ++b)
#pragma unroll
            for (int m = 0; m < 4; ++m)
#pragma unroll
                for (int n = 0; n < 2; ++n) acc[a][b][m][n] = (f32x4){0.f, 0.f, 0.f, 0.f};
    unsigned aoff[2][4], boff[2][2];
#pragma unroll
    for (int ai = 0; ai < 2; ++ai)
#pragma unroll
        for (int m = 0; m < 4; ++m) aoff[ai][m] = arow(128 * ai + 64 * wr + 16 * m + fr) + 8 * fq;
#pragma unroll
    for (int bj = 0; bj < 2; ++bj)
#pragma unroll
        for (int n = 0; n < 2; ++n) boff[bj][n] = (unsigned)(128 * bj + 32 * wc + perm32(16 * n + fr)) * (unsigned)K + 8 * fq;
#pragma unroll 1
    for (int k0 = 0; k0 < K; k0 += 32) {
        bf16x8 b[2][2];
#pragma unroll
        for (int bj = 0; bj < 2; ++bj)
#pragma unroll
            for (int n = 0; n < 2; ++n) b[bj][n] = *(const bf16x8*)(Btile + boff[bj][n] + k0);
#pragma unroll
        for (int ai = 0; ai < 2; ++ai) {
            bf16x8 a[4];
#pragma unroll
            for (int m = 0; m < 4; ++m) a[m] = *(const bf16x8*)(A + aoff[ai][m] + k0);
#pragma unroll
            for (int bj = 0; bj < 2; ++bj)
#pragma unroll
                for (int m = 0; m < 4; ++m)
#pragma unroll
                    for (int n = 0; n < 2; ++n) acc[ai][bj][m][n] = MFMA16(b[bj][n], a[m], acc[ai][bj][m][n]);
        }
    }
    E(acc, u, wr, wc, fr, fq);
}
struct RowLinear { unsigned row0, ld; __device__ __forceinline__ unsigned operator()(int r) const { return (row0 + (unsigned)r) * ld; } };

#define EPI_LOOP for (int ai = 0; ai < 2; ++ai) for (int m = 0; m < 4; ++m) for (int bj = 0; bj < 2; ++bj)
struct EpiStoreBf16 {
    static constexpr bool PERM = true, AFTER_DRAIN = false;
    bf16_t* O; int ld;
    __device__ __forceinline__ void operator()(const f32x4 (&acc)[2][2][4][2], const Unit& u, int wr, int wc, int fr, int fq) const {
#pragma unroll
        for (int ai = 0; ai < 2; ++ai)
#pragma unroll
            for (int m = 0; m < 4; ++m)
#pragma unroll
                for (int bj = 0; bj < 2; ++bj) {
                    const size_t row = (size_t)u.pm * 256 + 128 * ai + 64 * wr + 16 * m + fr; const int col = u.pn * 256 + 128 * bj + 32 * wc + 8 * fq;
                    const f32x4 v0 = acc[ai][bj][m][0], v1 = acc[ai][bj][m][1];
                    u32x4 w = {pk2(v0[0], v0[1]), pk2(v0[2], v0[3]), pk2(v1[0], v1[1]), pk2(v1[2], v1[3])};
                    *(u32x4*)(O + row * ld + col) = w;
                }
    }
};
struct EpiB1a {
    static constexpr bool PERM = true, AFTER_DRAIN = false;
    bf16_t* M1; const bf16_t* PROJ;
    __device__ __forceinline__ void operator()(const f32x4 (&acc)[2][2][4][2], const Unit& u, int wr, int wc, int fr, int fq) const {
#pragma unroll
        for (int ai = 0; ai < 2; ++ai)
#pragma unroll
            for (int m = 0; m < 4; ++m)
#pragma unroll
                for (int bj = 0; bj < 2; ++bj) {
                    const size_t row = (size_t)u.pm * 256 + 128 * ai + 64 * wr + 16 * m + fr; const int col = u.pn * 256 + 128 * bj + 32 * wc + 8 * fq;
                    const u32x4 g = *(const u32x4*)(PROJ + row * NPROJ + C_MGL + col);
                    const f32x4 v0 = acc[ai][bj][m][0], v1 = acc[ai][bj][m][1];
                    f32x4 o0 = {sigmoidf_(bflo(g[0])) * v0[0], sigmoidf_(bfhi(g[0])) * v0[1], sigmoidf_(bflo(g[1])) * v0[2], sigmoidf_(bfhi(g[1])) * v0[3]};
                    f32x4 o1 = {sigmoidf_(bflo(g[2])) * v1[0], sigmoidf_(bfhi(g[2])) * v1[1], sigmoidf_(bflo(g[3])) * v1[2], sigmoidf_(bfhi(g[3])) * v1[3]};
                    *(u32x4*)(M1 + row * D_ + col) = (u32x4){pk2(o0[0], o0[1]), pk2(o0[2], o0[3]), pk2(o1[0], o1[1]), pk2(o1[2], o1[3])};
                }
    }
};
struct EpiB1b {
    static constexpr bool PERM = true, AFTER_DRAIN = false;
    const bf16_t* M1; const bf16_t* PROJ; bf16_t* MERGED;
    __device__ __forceinline__ void operator()(const f32x4 (&acc)[2][2][4][2], const Unit& u, int wr, int wc, int fr, int fq) const {
#pragma unroll
        for (int ai = 0; ai < 2; ++ai)
#pragma unroll
            for (int m = 0; m < 4; ++m)
#pragma unroll
                for (int bj = 0; bj < 2; ++bj) {
                    const size_t row = (size_t)u.pm * 256 + 128 * ai + 64 * wr + 16 * m + fr; const int col = u.pn * 256 + 128 * bj + 32 * wc + 8 * fq;
                    const u32x4 g = *(const u32x4*)(PROJ + row * NPROJ + C_MGD + col);
                    const u32x4 mw = *(const u32x4*)(M1 + row * D_ + col); const f32x4 m0 = {bflo(mw[0]), bfhi(mw[0]), bflo(mw[1]), bfhi(mw[1])}, m1 = {bflo(mw[2]), bfhi(mw[2]), bflo(mw[3]), bfhi(mw[3])};
                    const f32x4 v0 = acc[ai][bj][m][0], v1 = acc[ai][bj][m][1];
                    f32x4 o0 = {m0[0] + sigmoidf_(bflo(g[0])) * v0[0], m0[1] + sigmoidf_(bfhi(g[0])) * v0[1], m0[2] + sigmoidf_(bflo(g[1])) * v0[2], m0[3] + sigmoidf_(bfhi(g[1])) * v0[3]};
                    f32x4 o1 = {m1[0] + sigmoidf_(bflo(g[2])) * v1[0], m1[1] + sigmoidf_(bfhi(g[2])) * v1[1], m1[2] + sigmoidf_(bflo(g[3])) * v1[2], m1[3] + sigmoidf_(bfhi(g[3])) * v1[3]};
                    *(u32x2*)((unsigned char*)MERGED + row * D_ + col) = (u32x2){pk4_fp8(o0[0], o0[1], o0[2], o0[3]), pk4_fp8(o1[0], o1[1], o1[2], o1[3])};
                }
    }
};
struct EpiB2 {
    static constexpr bool PERM = true, AFTER_DRAIN = false;
    const float* x; const float* gate; float* X1;
    __device__ __forceinline__ void operator()(const f32x4 (&acc)[2][2][4][2], const Unit& u, int wr, int wc, int fr, int fq) const {
#pragma unroll
        for (int ai = 0; ai < 2; ++ai)
#pragma unroll
            for (int m = 0; m < 4; ++m)
#pragma unroll
                for (int bj = 0; bj < 2; ++bj) {
                    const size_t row = (size_t)u.pm * 256 + 128 * ai + 64 * wr + 16 * m + fr; const int col = u.pn * 256 + 128 * bj + 32 * wc + 8 * fq;
#pragma unroll
                    for (int n = 0; n < 2; ++n) {
                        const f32x4 xv = *(const f32x4*)(x + row * D_ + col + 4 * n), gv = *(const f32x4*)(gate + col + 4 * n);
                        *(f32x4*)(X1 + row * D_ + col + 4 * n) = xv + gv * acc[ai][bj][m][n];
                    }
                }
    }
};
struct EpiF1 {
    static constexpr bool PERM = true, AFTER_DRAIN = false;
    float* LOGITS; bf16_t* HS;
    __device__ __forceinline__ void operator()(const f32x4 (&acc)[2][2][4][2], const Unit& u, int wr, int wc, int fr, int fq) const {
#pragma unroll
        for (int ai = 0; ai < 2; ++ai)
#pragma unroll
            for (int m = 0; m < 4; ++m) {
                const size_t row = (size_t)u.pm * 256 + 128 * ai + 64 * wr + 16 * m + fr;
                if (u.pn == 0) {
#pragma unroll
                    for (int bj = 0; bj < 2; ++bj)
#pragma unroll
                        for (int n = 0; n < 2; ++n) *(f32x4*)(LOGITS + row * 256 + 128 * bj + 32 * wc + 8 * fq + 4 * n) = acc[ai][bj][m][n];
                } else {
                    float h[8];
#pragma unroll
                    for (int n = 0; n < 2; ++n)
#pragma unroll
                        for (int i = 0; i < 4; ++i) h[4 * n + i] = siluf_(acc[ai][0][m][n][i]) * acc[ai][1][m][n][i];
                    u32x4 w = {pk2(h[0], h[1]), pk2(h[2], h[3]), pk2(h[4], h[5]), pk2(h[6], h[7])};
                    *(u32x4*)(HS + row * 256 + (u.pn - 1) * 128 + 32 * wc + 8 * fq) = w;
                }
            }
    }
};
struct EpiM1 {
    bf16_t* HE; int cstart, cnt;
    __device__ __forceinline__ void operator()(const f32x4 (&acc)[2][2][4][2], const Unit& u, int wr, int wc, int fr, int fq) const {
#pragma unroll
        for (int ai = 0; ai < 2; ++ai)
#pragma unroll
            for (int m = 0; m < 4; ++m) {
                const int pos = u.pm * 256 + 128 * ai + 64 * wr + 16 * m + fr;
                if (pos < cnt) {
                    float h[8];
#pragma unroll
                    for (int n = 0; n < 2; ++n)
#pragma unroll
                        for (int i = 0; i < 4; ++i) h[4 * n + i] = siluf_(acc[ai][0][m][n][i]) * acc[ai][1][m][n][i];
                    u32x4 w = {pk2(h[0], h[1]), pk2(h[2], h[3]), pk2(h[4], h[5]), pk2(h[6], h[7])};
                    *(u32x4*)(HE + (size_t)(cstart + pos) * 256 + u.pn * 128 + 32 * wc + 8 * fq) = w;
                }
            }
    }
};
struct EpiM2 {
    bf16_t* YS; const float* wl; int cstart, cnt;
    __device__ __forceinline__ void operator()(const f32x4 (&acc)[2][2][4][2], const Unit& u, int wr, int wc, int fr, int fq) const {
#pragma unroll
        for (int ai = 0; ai < 2; ++ai)
#pragma unroll
            for (int m = 0; m < 4; ++m) {
                const int pos = u.pm * 256 + 128 * ai + 64 * wr + 16 * m + fr;
                if (pos < cnt) {
                    const float wt = wl[pos];
#pragma unroll
                    for (int bj = 0; bj < 2; ++bj) {
                        const int col = u.pn * 256 + 128 * bj + 32 * wc + 8 * fq;
                        const f32x4 v0 = acc[ai][bj][m][0] * wt, v1 = acc[ai][bj][m][1] * wt;
                        u32x4 w = {pk2(v0[0], v0[1]), pk2(v0[2], v0[3]), pk2(v1[0], v1[1]), pk2(v1[2], v1[3])};
                        *(u32x4*)(YS + (size_t)(cstart + pos) * D_ + col) = w;
                    }
                }
            }
    }
};

__device__ __forceinline__ void conv_tile(const float* __restrict__ src, int ldN, int k0, int n0, bf16_t* __restrict__ dst, int ldK, int dst_row0, float* tile) {
    const int tid = tid_();
    {
        const int r = tid >> 4, c4 = tid & 15;
#pragma unroll
        for (int i = 0; i < 2; ++i) {
            const int row = r + 32 * i;
            const f32x4 v = *(const f32x4*)(src + (size_t)(k0 + row) * ldN + n0 + 4 * c4);
            tile[row * 65 + 4 * c4 + 0] = v[0]; tile[row * 65 + 4 * c4 + 1] = v[1]; tile[row * 65 + 4 * c4 + 2] = v[2]; tile[row * 65 + 4 * c4 + 3] = v[3];
        }
    }
    __syncthreads();
    {
        const int n = tid >> 3, kq = tid & 7;
        float f[8];
#pragma unroll
        for (int j = 0; j < 8; ++j) f[j] = tile[(8 * kq + j) * 65 + n];
        u32x4 w = {pk2(f[0], f[1]), pk2(f[2], f[3]), pk2(f[4], f[5]), pk2(f[6], f[7])};
        *(u32x4*)(dst + (size_t)(dst_row0 + n) * ldK + k0 + 8 * kq) = w;
    }
    __syncthreads();
}
__device__ __forceinline__ void conv_tile_f8(const float* __restrict__ src, int ldN, int k0, int n0, unsigned char* __restrict__ dst, int ldK, int dst_row0, float* tile) {
    const int tid = tid_();
    {
        const int r = tid >> 4, c4 = tid & 15;
#pragma unroll
        for (int i = 0; i < 2; ++i) {
            const int row = r + 32 * i;
            const f32x4 v = *(const f32x4*)(src + (size_t)(k0 + row) * ldN + n0 + 4 * c4);
            tile[row * 65 + 4 * c4 + 0] = v[0]; tile[row * 65 + 4 * c4 + 1] = v[1]; tile[row * 65 + 4 * c4 + 2] = v[2]; tile[row * 65 + 4 * c4 + 3] = v[3];
        }
    }
    __syncthreads();
    {
        const int n = tid >> 3, kq = tid & 7;
        float f[8];
#pragma unroll
        for (int j = 0; j < 8; ++j) f[j] = tile[(8 * kq + j) * 65 + n] * 32.0f;
        *(u32x2*)(dst + (size_t)(dst_row0 + n) * ldK + k0 + 8 * kq) = (u32x2){pk4_fp8(f[0], f[1], f[2], f[3]), pk4_fp8(f[4], f[5], f[6], f[7])};
    }
    __syncthreads();
}
constexpr int NT_WIN = 2048, NT_SQ = 768, NT_WF = 192, NT_WSD = 64, NT_EGU = 256 * 128, NT_ED = 256 * 64;
constexpr int NT_ALL = NT_WIN + NT_SQ + NT_WF + NT_WSD;
__device__ __forceinline__ void conv_job(const P& p, int idx, float* tile) {
    unsigned char* ws = p.ws;
    if (idx < NT_WIN) { const int nb = idx >> 4, kb = idx & 15; const int n0 = 64 * nb + (64 * nb >= 2048 ? 16 : 0);
        conv_tile_f8(p.w_in, 8208, 64 * kb, n0, ws + OFF_WINT, 1024, 64 * nb, tile); return; }
    idx -= NT_WIN;
    if (idx < NT_SQ) { const int mat = idx >> 8, rem = idx & 255, nb = rem >> 4, kb = rem & 15;
        const float* src = mat == 0 ? p.w_bg : (mat == 1 ? p.w_bd : p.w_out); unsigned char* dst = ws + (mat == 0 ? OFF_WBG : (mat == 1 ? OFF_WBD : OFF_WO));
        conv_tile_f8(src, 1024, 64 * kb, 64 * nb, dst, 1024, 64 * nb, tile); return; }
    idx -= NT_SQ;
    if (idx < NT_WF) { const int nbd = idx >> 4, kb = idx & 15; bf16_t* dst = (bf16_t*)(ws + OFF_WF);
        if (nbd < 4) { conv_tile(p.w_router, 256, 64 * kb, 64 * nbd, dst, 1024, 64 * nbd, tile); }
        else { const int q = nbd - 4, tl = q >> 2, part = q & 3; const float* src = part < 2 ? p.w_sg : p.w_su;
            conv_tile(src, 256, 64 * kb, 128 * tl + 64 * (part & 1), dst, 1024, 64 * nbd, tile); }
        return; }
    idx -= NT_WF;
    if (idx < NT_WSD) { const int nb = idx >> 2, kb = idx & 3; conv_tile(p.w_sd, 1024, 64 * kb, 64 * nb, (bf16_t*)(ws + OFF_WSD), 256, 64 * nb, tile); return; }
    idx -= NT_WSD;
    if (idx < NT_EGU) { const int e = idx >> 7, rem = idx & 127, nbd = rem >> 4, kb = rem & 15, tl = nbd >> 2, part = nbd & 3;
        const float* src = (part < 2 ? p.w_eg : p.w_eu) + (size_t)e * 1024 * 256;
        conv_tile(src, 256, 64 * kb, 128 * tl + 64 * (part & 1), (bf16_t*)(ws + OFF_WGU) + (size_t)e * 512 * 1024, 1024, 64 * nbd, tile); return; }
    idx -= NT_EGU;
    { const int e = idx >> 6, rem = idx & 63, nb = rem >> 2, kb = rem & 3;
        conv_tile(p.w_ed + (size_t)e * 256 * 1024, 1024, 64 * kb, 64 * nb, (bf16_t*)(ws + OFF_WD) + (size_t)e * 1024 * 256, 256, 64 * nb, tile); }
}
__device__ __forceinline__ void phase_p0(const P& p, unsigned char* smem, int bid, int G) {
    float* fs = (float*)smem;
    const int tid = tid_();
    for (int u = bid; u < 192; u += G) {
        for (int k = tid; k < 1024; k += NTHR) fs[k] = siluf_(p.c[k]);
        __syncthreads();
        const int kg = tid >> 5, col = tid & 31; float s = 0.f;
#pragma unroll 16
        for (int k = kg; k < 1024; k += 16) s += fs[k] * __builtin_nontemporal_load(p.w_ada + (size_t)k * 6144 + 32 * u + col);
        fs[1024 + tid] = s;
        __syncthreads();
        if (tid < 32) { float t = 0.f;
#pragma unroll
            for (int g = 0; g < 16; ++g) t += fs[1024 + 32 * g + tid];
            ((float*)(p.ws + OFF_MOD))[32 * u + tid] = t + p.b_ada[32 * u + tid]; }
        __syncthreads();
    }
    for (int i = bid * NTHR + tid; i < 16 * 1024; i += G * NTHR) { const int j = i >> 10, k = i & 1023; ((bf16_t*)(p.ws + OFF_WAT))[i] = (bf16_t)f2bf(p.w_in[(size_t)k * 8208 + 2048 + j]); }
}
__device__ __forceinline__ void phase_conv(const P& p, unsigned char* smem, int bid, int G, int j0, int j1) {
    __syncthreads();
    for (int t = j0 + bid; t < j1; t += G) conv_job(p, t, (float*)smem + 1536);
}

__device__ __forceinline__ void phase_norm(const float* __restrict__ x, const float* __restrict__ g, const float* __restrict__ sc, const float* __restrict__ sh, bf16_t* __restrict__ out, unsigned char* __restrict__ out8, int bid, int G) {
    const int tid = tid_(), wid = tid >> 6, lane = tid & 63;
    for (int row = bid * 8 + wid; row < T_; row += G * 8) {
        f32x4 v[4]; float ss = 0.f;
#pragma unroll
        for (int j = 0; j < 4; ++j) { v[j] = *(const f32x4*)(x + (size_t)row * D_ + 256 * j + 4 * lane); ss += v[j][0] * v[j][0] + v[j][1] * v[j][1] + v[j][2] * v[j][2] + v[j][3] * v[j][3]; }
        ss = wave_sum(ss);
        const float rstd = rsqrtf(ss * (1.0f / 1024.0f) + EPS);
#pragma unroll
        for (int j = 0; j < 4; ++j) { const int c = 256 * j + 4 * lane;
            const f32x4 gg = *(const f32x4*)(g + c), s1 = *(const f32x4*)(sc + c), s0 = *(const f32x4*)(sh + c);
            f32x4 y = v[j] * rstd * gg * (s1 + 1.0f) + s0;
            u32x2 w = {pk2(y[0], y[1]), pk2(y[2], y[3])};
            *(u32x2*)(out + (size_t)row * D_ + c) = w;
            if (out8) *(unsigned*)(out8 + (size_t)row * D_ + c) = pk4_fp8(y[0], y[1], y[2], y[3]); }
    }
}

constexpr float QSCALE = 0.125f * 1.4426950408889634f;
__device__ __forceinline__ float logsig(float z) { return fminf(z, 0.f) - __logf(1.0f + __expf(-fabsf(z))); }
__device__ __forceinline__ void prep_chunk(const P& p, int n, unsigned char* smem) {
    float* alow_s = (float*)smem;
    bf16_t* tt = (bf16_t*)(smem + 4096);
    const int tid = tid_(), wid = tid >> 6, lane = tid & 63;
    bf16_t* PROJ = (bf16_t*)(p.ws + OFF_PROJ); const bf16_t* H = (const bf16_t*)(p.ws + OFF_H); const bf16_t* WaT = (const bf16_t*)(p.ws + OFF_WAT);
    if (wid < 4) {
        const int fr = lane & 15, fq = lane >> 4; f32x4 acc = {0.f, 0.f, 0.f, 0.f};
        const bf16_t* ap = H + (size_t)(64 * n + 16 * wid + fr) * D_ + 8 * fq; const bf16_t* bp = WaT + (size_t)fr * D_ + 8 * fq;
#pragma unroll 1
        for (int k0 = 0; k0 < D_; k0 += 256) { bf16x8 av[8], bv[8];
#pragma unroll
            for (int j = 0; j < 8; ++j) { av[j] = *(const bf16x8*)(ap + k0 + 32 * j); bv[j] = *(const bf16x8*)(bp + k0 + 32 * j); }
#pragma unroll
            for (int j = 0; j < 8; ++j) acc = MFMA16(av[j], bv[j], acc); }
#pragma unroll
        for (int r = 0; r < 4; ++r) alow_s[(16 * wid + 4 * fq + r) * 16 + fr] = acc[r];
    }
    __syncthreads();
    {
        const int ch = tid; float w2[16];
#pragma unroll
        for (int j = 0; j < 16; ++j) w2[j] = p.gla_w_a2[j * 512 + ch];
        const float bb = p.gla_b_a[ch]; float suf = 0.f; bf16_t* dst = (bf16_t*)(p.ws + OFF_KDT) + ((size_t)n * 512 + ch) * 64;
#pragma unroll 1
        for (int c32 = 1; c32 >= 0; --c32) {
            unsigned short kraw[32];
#pragma unroll
            for (int i = 0; i < 32; ++i) kraw[i] = PROJ[(size_t)(64 * n + 32 * c32 + i) * NPROJ + C_GK + ch];
#pragma unroll
            for (int c8 = 3; c8 >= 0; --c8) { float kd[8];
#pragma unroll
                for (int i = 7; i >= 0; --i) { const int c = 32 * c32 + 8 * c8 + i; float z = bb;
#pragma unroll
                    for (int j = 0; j < 16; ++j) z += alow_s[c * 16 + j] * w2[j];
                    kd[i] = bf2f(kraw[8 * c8 + i]) * __expf(suf);
                    suf += logsig(z) * (1.0f / 16.0f); }
                u32x4 w = {pk2(kd[0], kd[1]), pk2(kd[2], kd[3]), pk2(kd[4], kd[5]), pk2(kd[6], kd[7])};
                *(u32x4*)(dst + 32 * c32 + 8 * c8) = w; }
        }
        ((float*)(p.ws + OFF_DEC))[n * 512 + ch] = __expf(suf);
    }
#pragma unroll 1
    for (int piece = 0; piece < 4; ++piece) {
        const int mat = piece >> 1, cb = (mat == 0 ? C_GV : C_DV) + 512 * (piece & 1);
        __syncthreads();
        { u32x4 v[8];
#pragma unroll
          for (int i = 0; i < 8; ++i) { const int pidx = tid + NTHR * i, c = pidx >> 6, q16 = pidx & 63; v[i] = *(const u32x4*)(PROJ + (size_t)(64 * n + c) * NPROJ + cb + 8 * q16); }
#pragma unroll
          for (int i = 0; i < 8; ++i) { const int pidx = tid + NTHR * i, c = pidx >> 6, q16 = pidx & 63; *(u32x4*)(tt + c * 520 + 8 * q16) = v[i]; } }
        __syncthreads();
        const int col = 512 * (piece & 1) + tid;
        if (mat == 0) {
            bf16_t* dst = (bf16_t*)(p.ws + OFF_VTG) + ((size_t)n * 1024 + col) * 64;
#pragma unroll
            for (int cq = 0; cq < 4; ++cq) { unsigned w[8];
#pragma unroll
                for (int j = 0; j < 8; ++j) w[j] = (unsigned)tt[(16 * cq + 2 * j) * 520 + tid] | ((unsigned)tt[(16 * cq + 2 * j + 1) * 520 + tid] << 16);
                *(u32x4*)(dst + 16 * cq) = (u32x4){w[0], w[1], w[2], w[3]}; *(u32x4*)(dst + 16 * cq + 8) = (u32x4){w[4], w[5], w[6], w[7]}; }
        } else {
            unsigned char* dst = p.ws + OFF_V8T + (size_t)col * T_ + 64 * n;
#pragma unroll
            for (int q = 0; q < 4; ++q) { unsigned w[4];
#pragma unroll
                for (int j = 0; j < 4; ++j) { float f[4];
#pragma unroll
                    for (int e = 0; e < 4; ++e) { const int g = 4 * j + e, key = 32 * (q & 1) + crow(g, q >> 1); f[e] = bf2f(tt[key * 520 + tid]); }
                    w[j] = pk4_fp8(f[0], f[1], f[2], f[3]); }
                *(u32x4*)(dst + 16 * q) = (u32x4){w[0], w[1], w[2], w[3]}; }
        }
    }
#pragma unroll 1
    for (int i0 = 0; i0 < 16; i0 += 4) {
        u32x4 ra[4], rb[4];
#pragma unroll
        for (int ii = 0; ii < 4; ++ii) { const int idx = wid * 16 + i0 + ii, which = idx >> 6, c = idx & 63;
            const bf16_t* base = PROJ + (size_t)(64 * n + c) * NPROJ + (which ? C_DK : C_DQ) + 16 * lane; ra[ii] = *(const u32x4*)base; rb[ii] = *(const u32x4*)(base + 8); }
#pragma unroll
        for (int ii = 0; ii < 4; ++ii) {
            const int idx = wid * 16 + i0 + ii, which = idx >> 6, c = idx & 63, t = 64 * n + c;
            const u32x4 a = ra[ii], b = rb[ii];
            float v[16];
#pragma unroll
            for (int j = 0; j < 4; ++j) { v[2 * j] = bflo(a[j]); v[2 * j + 1] = bfhi(a[j]); v[8 + 2 * j] = bflo(b[j]); v[8 + 2 * j + 1] = bfhi(b[j]); }
            float ss = 0.f;
#pragma unroll
            for (int j = 0; j < 16; ++j) ss += v[j] * v[j];
            ss += __shfl_xor(ss, 1); ss += __shfl_xor(ss, 2);
            const float rstd = rsqrtf(ss * (1.0f / 64.0f) + EPS);
            const float* g = (which ? p.kn_g : p.qn_g) + 16 * (lane & 3);
#pragma unroll
            for (int j = 0; j < 16; ++j) v[j] = v[j] * rstd * g[j];
            if ((lane & 3) == 0) {
                const float pos = (float)p.pos[t];
#pragma unroll
                for (int j = 0; j < 8; ++j) {
                    const float ang = pos * p.invf[j];
                    const double rev = (double)ang * 0.15915494309189535; const float fr = (float)(rev - floor(rev));
                    const float cs = __builtin_amdgcn_cosf(fr), sn = __builtin_amdgcn_sinf(fr);
                    const float t1 = v[j], t2 = v[8 + j]; v[j] = t1 * cs - t2 * sn; v[8 + j] = t2 * cs + t1 * sn; }
            }
            const float qs = which ? 1.0f : 1.4426950408889634f;
            u32x4 o8;
#pragma unroll
            for (int j = 0; j < 4; ++j) o8[j] = pk4_fp8(v[4 * j] * qs, v[4 * j + 1] * qs, v[4 * j + 2] * qs, v[4 * j + 3] * qs);
            *(u32x4*)(p.ws + (which ? OFF_K8 : OFF_Q8) + (size_t)t * D_ + 16 * lane) = o8;
        }
    }
}

template <bool FINAL>
__device__ __forceinline__ void gla_unit(const P& p, int s, int h, unsigned char* smem) {
    const int tid = tid_(), wid = tid >> 6, lane = tid & 63, r = lane & 31, hi = lane >> 5;
    const bf16_t* PROJ = (const bf16_t*)(p.ws + OFF_PROJ); const bf16_t* KDT = (const bf16_t*)(p.ws + OFF_KDT); const bf16_t* VTG = (const bf16_t*)(p.ws + OFF_VTG);
    const float* DEC = (const float*)(p.ws + OFF_DEC);
    float* o_s = (float*)(smem + 32768);
    LAS unsigned char* q_s = (LAS unsigned char*)smem;
    const int qrow_ = tid >> 3, qch_ = tid & 7;
    u32x4 qpre0 = {0u, 0u, 0u, 0u}, qpre1 = {0u, 0u, 0u, 0u};
    if (FINAL) { const bf16_t* qp_ = PROJ + (size_t)(64 * (4 * s) + qrow_) * NPROJ + C_GQ + h * 128 + 8 * qch_; qpre0 = *(const u32x4*)qp_; qpre1 = *(const u32x4*)(qp_ + 64); }
    f32x16 st[4];
    const size_t sbase = ((size_t)s * 4 + h) * 128 * 256;
    if (FINAL) { const bf16_t* CARRY = (const bf16_t*)(p.ws + OFF_CARRY) + sbase;
#pragma unroll
        for (int b = 0; b < 4; ++b)
#pragma unroll
            for (int g = 0; g < 16; ++g) st[b][g] = bf2f(CARRY[(size_t)(32 * b + crow(g, hi)) * 256 + 32 * wid + r]);
    } else {
#pragma unroll
        for (int b = 0; b < 4; ++b)
#pragma unroll
            for (int g = 0; g < 16; ++g) st[b][g] = 0.f;
    }
    LAS unsigned char* dec_s = (LAS unsigned char*)smem + 16896;
    __syncthreads();
    *(LAS float*)(dec_s + 4 * tid) = DEC[(4 * s + (tid >> 7)) * 512 + h * 128 + (tid & 127)];
    __syncthreads();
    bf16x8 vbN[4], kaN[4][4];
#pragma unroll
    for (int ks = 0; ks < 4; ++ks) { vbN[ks] = *(const bf16x8*)(VTG + ((size_t)(4 * s) * 1024 + h * 256 + 32 * wid + r) * 64 + 16 * ks + 8 * hi);
#pragma unroll
        for (int b = 0; b < 4; ++b) kaN[ks][b] = *(const bf16x8*)(KDT + ((size_t)(4 * s) * 512 + h * 128 + 32 * b + r) * 64 + 16 * ks + 8 * hi); }
#pragma unroll 1
    for (int cn = 0; cn < 4; ++cn) {
        const int n = 4 * s + cn;
        if (FINAL) {
            { LAS unsigned char* qd_ = q_s + qrow_ * 264 + 16 * qch_;
              *(LAS u32x2*)qd_ = (u32x2){qpre0[0], qpre0[1]}; *(LAS u32x2*)(qd_ + 8) = (u32x2){qpre0[2], qpre0[3]}; *(LAS u32x2*)(qd_ + 128) = (u32x2){qpre1[0], qpre1[1]}; *(LAS u32x2*)(qd_ + 136) = (u32x2){qpre1[2], qpre1[3]}; }
            if (cn < 3) { const bf16_t* qp_ = PROJ + (size_t)(64 * (n + 1) + qrow_) * NPROJ + C_GQ + h * 128 + 8 * qch_; qpre0 = *(const u32x4*)qp_; qpre1 = *(const u32x4*)(qp_ + 64); }
        }
#pragma unroll
        for (int b = 0; b < 4; ++b)
#pragma unroll
            for (int g4 = 0; g4 < 4; ++g4) { const f32x4 d = *(LAS const f32x4*)(dec_s + 4 * (cn * 128 + 32 * b + 8 * g4 + 4 * hi));
#pragma unroll
                for (int i = 0; i < 4; ++i) st[b][4 * g4 + i] *= d[i]; }
#pragma unroll
        for (int ks = 0; ks < 4; ++ks) {
#pragma unroll
            for (int b = 0; b < 4; ++b) st[b] = MFMA32(kaN[ks][b], vbN[ks], st[b]);
        }
        if (cn < 3) {
#pragma unroll
            for (int ks = 0; ks < 4; ++ks) { vbN[ks] = *(const bf16x8*)(VTG + ((size_t)(n + 1) * 1024 + h * 256 + 32 * wid + r) * 64 + 16 * ks + 8 * hi);
#pragma unroll
                for (int b = 0; b < 4; ++b) kaN[ks][b] = *(const bf16x8*)(KDT + ((size_t)(n + 1) * 512 + h * 128 + 32 * b + r) * 64 + 16 * ks + 8 * hi); }
        }
        if (FINAL) {
            f32x16 o[2];
#pragma unroll
            for (int tb = 0; tb < 2; ++tb)
#pragma unroll
                for (int g = 0; g < 16; ++g) o[tb][g] = 0.f;
            __syncthreads();
#pragma unroll
            for (int b = 0; b < 4; ++b)
#pragma unroll
                for (int s2 = 0; s2 < 2; ++s2) {
                    u32x4 sb = {pk2(st[b][8 * s2 + 0], st[b][8 * s2 + 1]), pk2(st[b][8 * s2 + 2], st[b][8 * s2 + 3]), pk2(st[b][8 * s2 + 4], st[b][8 * s2 + 5]), pk2(st[b][8 * s2 + 6], st[b][8 * s2 + 7])};
#pragma unroll
                    for (int tb = 0; tb < 2; ++tb) {
                        LAS const unsigned char* qp = q_s + (32 * tb + r) * 264 + 2 * (32 * b + 16 * s2 + 4 * hi);
                        const u32x2 q0 = *(LAS const u32x2*)qp, q1 = *(LAS const u32x2*)(qp + 16);
                        u32x4 qa = {q0[0], q0[1], q1[0], q1[1]};
                        o[tb] = MFMA32(__builtin_bit_cast(bf16x8, qa), __builtin_bit_cast(bf16x8, sb), o[tb]);
                    }
                }
            __syncthreads();
#pragma unroll
            for (int tb = 0; tb < 2; ++tb)
#pragma unroll
                for (int g = 0; g < 16; ++g) o_s[(32 * tb + crow(g, hi)) * 256 + 32 * wid + r] = o[tb][g] * 0.08838834764831845f;
            __syncthreads();
            bf16_t* OGLA = (bf16_t*)(p.ws + OFF_OGLA);
#pragma unroll
            for (int i = 0; i < 8; ++i) {
                const int c = 8 * wid + i; const size_t t = (size_t)64 * n + c;
                const f32x4 v = *(const f32x4*)(o_s + c * 256 + 4 * lane);
                float ss = wave_sum(v[0] * v[0] + v[1] * v[1] + v[2] * v[2] + v[3] * v[3]);
                const float rstd = rsqrtf(ss * (1.0f / 256.0f) + EPS);
                const f32x4 gn = *(const f32x4*)(p.gla_onorm_g + 4 * lane);
                const u32x2 gg = *(const u32x2*)(PROJ + t * NPROJ + C_GG + h * 256 + 4 * lane);
                const float y0 = v[0] * rstd * gn[0] * siluf_(bflo(gg[0])), y1 = v[1] * rstd * gn[1] * siluf_(bfhi(gg[0])), y2 = v[2] * rstd * gn[2] * siluf_(bflo(gg[1])), y3 = v[3] * rstd * gn[3] * siluf_(bfhi(gg[1]));
                *(unsigned*)((unsigned char*)OGLA + t * D_ + h * 256 + 4 * lane) = pk4_fp8(y0, y1, y2, y3);
            }
        }
    }
    if (!FINAL) { bf16_t* LOC = (bf16_t*)(p.ws + OFF_LOC) + sbase;
#pragma unroll
        for (int b = 0; b < 4; ++b)
#pragma unroll
            for (int g = 0; g < 16; ++g) LOC[(size_t)(32 * b + crow(g, hi)) * 256 + 32 * wid + r] = (bf16_t)f2bf(st[b][g]);
    }
}
__device__ __forceinline__ void phase_g2(const P& p, int bid, int G) {
    const bf16_t* LOC = (const bf16_t*)(p.ws + OFF_LOC); bf16_t* CARRY = (bf16_t*)(p.ws + OFF_CARRY); const float* DEC = (const float*)(p.ws + OFF_DEC);
    for (int e = bid * NTHR + tid_(); e < 131072; e += G * NTHR) {
        const int h = e >> 15, dk = (e >> 8) & 127; float carry = 0.f;
        const float* d0 = DEC + h * 128 + dk;
#pragma unroll 1
        for (int s0 = 0; s0 < 64; s0 += 16) {
            float lv[16], pd[16];
#pragma unroll
            for (int i = 0; i < 16; ++i) { const float* d = d0 + (4 * (s0 + i)) * 512; lv[i] = bf2f(LOC[(size_t)(s0 + i) * 131072 + e]); pd[i] = d[0] * d[512] * d[1024] * d[1536]; }
#pragma unroll
            for (int i = 0; i < 16; ++i) { CARRY[(size_t)(s0 + i) * 131072 + e] = (bf16_t)f2bf(carry); carry = lv[i] + pd[i] * carry; }
        }
    }
}

constexpr int ATT_STAGE = 32768;
typedef int i32x8a __attribute__((ext_vector_type(8)));
typedef int i32x4a __attribute__((ext_vector_type(4)));
typedef short s16x2a __attribute__((ext_vector_type(2)));
__device__ __forceinline__ int pk4_fp8_div(float a, float b, float c, float d, float scale) { s16x2a w = {0, 0}; w = __builtin_amdgcn_cvt_scalef32_pk_fp8_f32(w, a, b, scale, false); w = __builtin_amdgcn_cvt_scalef32_pk_fp8_f32(w, c, d, scale, true); return __builtin_bit_cast(int, w); }
__device__ __forceinline__ i32x8a cat16u(u32x4 lo, u32x4 hi) { return __builtin_shufflevector(__builtin_bit_cast(i32x4a, lo), __builtin_bit_cast(i32x4a, hi), 0, 1, 2, 3, 4, 5, 6, 7); }
template <int AV>
__device__ __forceinline__ void attn_unit(const P& p, int h, int qb, unsigned char* smem) {
    const int tid = tid_(), lane = tid & 63, r = lane & 31, hi = lane >> 5; const int wid = __builtin_amdgcn_readfirstlane(tid >> 6);
    const unsigned char* K8 = p.ws + OFF_K8 + h * 128; const unsigned char* V8T = p.ws + OFF_V8T + (size_t)h * 128 * T_;
    LAS unsigned char* lds = (LAS unsigned char*)smem;
    const int q0 = qb * 256 + wid * 32, qc = q0 >> 6, nt = 2 * qb + 2;
#define ATT_STAGE_TILE(kt, buf) do { const int t3_ = tid_(); const unsigned srow_ = (unsigned)(t3_ >> 3), sch_ = (unsigned)((t3_ & 7) ^ ((t3_ >> 4) & 7)); \
        _Pragma("unroll") for (int j_ = 0; j_ < 2; ++j_) { \
        __builtin_amdgcn_global_load_lds((const unsigned*)(K8 + ((size_t)(kt) * 128 + 64 * j_ + srow_) * D_ + 16 * sch_), (LAS unsigned*)(lds + (buf) * ATT_STAGE + (512 * j_ + 64 * wid) * 16), 16, 0, 0); \
        __builtin_amdgcn_global_load_lds((const unsigned*)(V8T + (size_t)(64 * j_ + srow_) * T_ + (size_t)(kt) * 128 + 16 * sch_), (LAS unsigned*)(lds + (buf) * ATT_STAGE + 16384 + (512 * j_ + 64 * wid) * 16), 16, 0, 0); } } while (0)
    const unsigned FX = (unsigned)r * 128u + ((unsigned)((2 * hi) ^ ((r >> 1) & 7)) << 4);
    ATT_STAGE_TILE(0, 0);
    LAS unsigned char* qbase = lds + 3 * ATT_STAGE + wid * 4096;
    { const unsigned char* qrow = p.ws + OFF_Q8 + (size_t)(q0 + r) * D_ + h * 128 + 32 * hi;
#pragma unroll
      for (int m = 0; m < 2; ++m) { *(LAS u32x4*)(qbase + (FX ^ (unsigned)(64 * m))) = *(const u32x4*)(qrow + 64 * m); *(LAS u32x4*)(qbase + (FX ^ (unsigned)(64 * m + 16))) = *(const u32x4*)(qrow + 64 * m + 16); } }
    float noff;
    { int z = 0; asm volatile("" : "+v"(z)); float gq = 0.f, gk = 0.f;
      for (int i = 0; i < 64; ++i) { gq = fmaxf(gq, fabsf(p.qn_g[i + z])); gk = fmaxf(gk, fabsf(p.kn_g[i + z])); }
      noff = exp2f(ceilf(8.0f * 1.4426950408889634f * gq * gk) - 8.0f); }
    f32x16 O[2][4]; f32x2v la0 = {0.f, 0.f}, la1 = {0.f, 0.f};
#pragma unroll
    for (int m = 0; m < 2; ++m)
#pragma unroll
        for (int d = 0; d < 4; ++d)
#pragma unroll
            for (int g = 0; g < 16; ++g) O[m][d][g] = 0.f;
    i32x8a p8[2];
#pragma unroll
    for (int m = 0; m < 2; ++m)
#pragma unroll
        for (int g = 0; g < 8; ++g) p8[m][g] = 0;
    const f32x16 zero16 = {0.f, 0.f, 0.f, 0.f, 0.f, 0.f, 0.f, 0.f, 0.f, 0.f, 0.f, 0.f, 0.f, 0.f, 0.f, 0.f};
#define ATT_KF(dst, kb_, m_) dst = cat16u(*(LAS const u32x4*)((kb_) + (FX ^ (unsigned)(64 * (m_)))), *(LAS const u32x4*)((kb_) + (FX ^ (unsigned)(64 * (m_) + 16))))
#define ATT_VF(dst, v0_, v1_, d_) dst = cat16u(*(LAS const u32x4*)((v0_) + 4096 * (d_)), *(LAS const u32x4*)((v1_) + 4096 * (d_)))
#define ATT_EXPG(SC, PM, PO, j_, SCL) do { if (AV == 1) { p8[1 - (PM)][(PO) + (j_)] = (int)(__float_as_uint(SC[4 * (j_)]) ^ __float_as_uint(SC[4 * (j_) + 1]) ^ __float_as_uint(SC[4 * (j_) + 2]) ^ __float_as_uint(SC[4 * (j_) + 3])); break; } \
        _Pragma("unroll") for (int g_ = 4 * (j_); g_ < 4 * (j_) + 4; ++g_) SC[g_] = __builtin_amdgcn_exp2f(SC[g_]); \
        int w_; asm("v_cvt_scalef32_pk_fp8_f32 %0, %1, %2, %3" : "=v"(w_) : "v"(SC[4 * (j_)]), "v"(SC[4 * (j_) + 1]), "v"(SCL)); \
        asm("v_cvt_scalef32_pk_fp8_f32 %0, %1, %2, %3 op_sel:[0,0,0,1]" : "+v"(w_) : "v"(SC[4 * (j_) + 2]), "v"(SC[4 * (j_) + 3]), "v"(SCL)); \
        p8[1 - (PM)][(PO) + (j_)] = w_; } while (0)
#define ATT_STEP(SC, SN, DO_S, PM, V0, V1, PD, PO, LA, NDO, NKB, NM, NQ, MV, SCL) do { \
        i32x8a va_, vb_; \
        ATT_VF(va_, V0, V1, PD); ATT_VF(vb_, V0, V1, (PD) + 1); \
        __builtin_amdgcn_sched_barrier(0); \
        ATT_EXPG(SC, PM, PO, 0, SCL); \
        if (DO_S) { SN = __builtin_amdgcn_mfma_scale_f32_32x32x64_f8f6f4(kfN, qN, zero16, 0, 0, 0, 0x7F7F7F7F, 0, 0x7C7C7C7C); asm volatile("" : "+v"(SN)); }     \
        __builtin_amdgcn_sched_group_barrier(0x400, 4, 0); __builtin_amdgcn_sched_group_barrier(0x008, 1, 0); \
        __builtin_amdgcn_sched_barrier(0); \
        ATT_EXPG(SC, PM, PO, 1, SCL); \
        O[PM][PD] = __builtin_amdgcn_mfma_scale_f32_32x32x64_f8f6f4(p8[PM], va_, O[PM][PD], 0, 0, 0, 0x7F7F7F7F, 0, 0x7F7F7F7F); \
        __builtin_amdgcn_sched_group_barrier(0x400, 4, 0); __builtin_amdgcn_sched_group_barrier(0x008, 1, 0); \
        __builtin_amdgcn_sched_barrier(0); \
        ATT_EXPG(SC, PM, PO, 2, SCL); \
        O[PM][(PD) + 1] = __builtin_amdgcn_mfma_scale_f32_32x32x64_f8f6f4(p8[PM], vb_, O[PM][(PD) + 1], 0, 0, 0, 0x7F7F7F7F, 0, 0x7F7F7F7F); \
        if (NDO) ATT_KF(kfN, NKB, NM); if (NQ) ATT_KF(qN, qbase, NM); \
        __builtin_amdgcn_sched_group_barrier(0x400, 4, 0); __builtin_amdgcn_sched_group_barrier(0x008, 1, 0); \
        __builtin_amdgcn_sched_barrier(0); \
        ATT_EXPG(SC, PM, PO, 3, SCL); \
        if (AV != 1) { _Pragma("unroll") for (int g_ = 0; g_ < 8; ++g_) LA = (f32x2v){SC[2 * g_], SC[2 * g_ + 1]} * (f32x2v){MV, MV} + LA; } \
        __builtin_amdgcn_sched_barrier(0); } while (0)
#define ATT_FLUSH(V0, V1) do { _Pragma("unroll") for (int d_ = 0; d_ < 4; ++d_) { i32x8a vf_; ATT_VF(vf_, V0, V1, d_); \
        O[1][d_] = __builtin_amdgcn_mfma_scale_f32_32x32x64_f8f6f4(p8[1], vf_, O[1][d_], 0, 0, 0, 0x7F7F7F7F, 0, 0x7F7F7F7F); } \
        __builtin_amdgcn_sched_barrier(0); } while (0)
    LAS const unsigned char* pv0 = lds + 16384 + FX; LAS const unsigned char* pv1 = lds + 16384 + (FX ^ 16u);
    asm volatile("s_waitcnt vmcnt(0)" ::: "memory"); __syncthreads();
    if (wid >= 4) __builtin_amdgcn_s_setprio(1);
    int st = 0, st1 = 1;
#pragma unroll 1
    for (int kt = 0; kt < nt; ++kt) {
        if (kt + 1 < nt) ATT_STAGE_TILE(kt + 1, st1);
        const int nch = qc - 2 * kt + 1;
        LAS const unsigned char* sb = lds + st * ATT_STAGE;
        {
            const float mv0 = nch >= 1 ? 1.f : 0.f, mv1 = nch >= 2 ? 1.f : 0.f, sc0 = nch >= 1 ? noff : 0x1p120f, sc1 = nch >= 2 ? noff : 0x1p120f;
            f32x16 SA, SB; i32x8a kfN, qN;
            ATT_KF(kfN, sb, 0); ATT_KF(qN, qbase, 0);
            SA = __builtin_amdgcn_mfma_scale_f32_32x32x64_f8f6f4(kfN, qN, zero16, 0, 0, 0, 0x7F7F7F7F, 0, 0x7C7C7C7C);
            __builtin_amdgcn_sched_barrier(0);
            ATT_KF(kfN, sb + 4096, 0);
            __builtin_amdgcn_sched_barrier(0);
            LAS const unsigned char* c0 = sb + 16384 + FX; LAS const unsigned char* c1 = sb + 16384 + (FX ^ 16u);
            ATT_STEP(SA, SB, true, 1, pv0, pv1, 0, 0, la0,  true, sb, 1, true, mv0, sc0);
            ATT_STEP(SB, SA, true, 1, pv0, pv1, 2, 4, la0,  true, sb + 4096, 1, false, mv0, sc0);
            ATT_STEP(SA, SB, true, 0, c0, c1, 0, 0, la1,    true, sb + 8192, 0, true, mv0, sc0);
            ATT_STEP(SB, SA, true, 0, c0, c1, 2, 4, la1,    true, sb + 12288, 0, false, mv0, sc0);
            pv0 = sb + 16384 + (FX ^ 64u); pv1 = sb + 16384 + (FX ^ 80u);
            ATT_STEP(SA, SB, true, 1, c0, c1, 0, 0, la0,    true, sb + 8192, 1, true, mv1, sc1);
            ATT_STEP(SB, SA, true, 1, c0, c1, 2, 4, la0,    true, sb + 12288, 1, false, mv1, sc1);
            ATT_STEP(SA, SB, true, 0, pv0, pv1, 0, 0, la1,  false, sb, 0, false, mv1, sc1);
            ATT_STEP(SB, SA, false, 0, pv0, pv1, 2, 4, la1, false, sb, 0, false, mv1, sc1);
        }
        asm volatile("s_waitcnt vmcnt(0)" ::: "memory"); __syncthreads();
        st = st1; st1 = st1 == 2 ? 0 : st1 + 1;
    }
    ATT_FLUSH(pv0, pv1);
    __syncthreads();
    __builtin_amdgcn_s_setprio(0);
    float l0 = la0[0] + la0[1], l1 = la1[0] + la1[1];
#undef ATT_KF
#undef ATT_VF
#undef ATT_EXPG
#undef ATT_STEP
#undef ATT_FLUSH
#undef ATT_STAGE_TILE
    {
        const int tid2 = tid_(), lane2 = tid2 & 63, r2 = lane2 & 31, hi2 = lane2 >> 5; const int wid2 = __builtin_amdgcn_readfirstlane(tid2 >> 6);
        const int q02 = qb * 256 + wid2 * 32;
        int z = 0; asm volatile("" : "+v"(z));
        float la = 0.f, lb = 0.f;
        for (int i = 0; i < 64; ++i) { la += p.lq1[i + z] * p.lk1[i + z]; lb += p.lq2[i + z] * p.lk2[i + z]; }
        const float lam = __expf(la) - __expf(lb) + 0.2f;
        l0 += __uint_as_float(__builtin_amdgcn_ds_bpermute((lane2 ^ 32) << 2, __float_as_uint(l0)));
        l1 += __uint_as_float(__builtin_amdgcn_ds_bpermute((lane2 ^ 32) << 2, __float_as_uint(l1)));
        float gq2 = 0.f, gk2 = 0.f;
        for (int i = 0; i < 64; ++i) { gq2 = fmaxf(gq2, fabsf(p.qn_g[i + z])); gk2 = fmaxf(gk2, fabsf(p.kn_g[i + z])); }
        const float unsc = exp2f(ceilf(8.0f * 1.4426950408889634f * gq2 * gk2) - 8.0f);
        const float i0 = unsc / l0, i1 = unsc * lam / l1;
        bf16_t* ODIFF = (bf16_t*)(p.ws + OFF_ODIFF);
        float sgv[4];
#pragma unroll
        for (int d = 0; d < 4; ++d) sgv[d] = p.subln_g[32 * d + r2 + z] * 0.8f;
#pragma unroll
        for (int g = 0; g < 16; ++g) {
            const int row = crow(g, hi2);
            const float a0 = __uint_as_float(__builtin_amdgcn_ds_bpermute(row << 2, __float_as_uint(i0))), a1 = __uint_as_float(__builtin_amdgcn_ds_bpermute(row << 2, __float_as_uint(i1)));
            float o[4], ss = 0.f;
#pragma unroll
            for (int d = 0; d < 4; ++d) { o[d] = O[0][d][g] * a0 - O[1][d][g] * a1; ss += o[d] * o[d]; }
#pragma unroll
            for (int of = 16; of >= 1; of >>= 1) ss += __uint_as_float(__builtin_amdgcn_ds_bpermute((lane2 ^ of) << 2, __float_as_uint(ss)));
            const float rstd = rsqrtf(ss * (1.0f / 128.0f) + EPS);
#pragma unroll
            for (int d = 0; d < 4; ++d) ((unsigned char*)ODIFF)[(size_t)(q02 + row) * D_ + h * 128 + 32 * d + r2] = (unsigned char)pk4_fp8(o[d] * rstd * sgv[d], 0.f, 0.f, 0.f);
        }
    }
}

template <int CTRL> __device__ __forceinline__ float dppf_(float x) { return __int_as_float(__builtin_amdgcn_update_dpp(0, __float_as_int(x), CTRL, 0xF, 0xF, false)); }
template <bool PROBE = false>
__device__ __forceinline__ void phase_route(const P& p, int bid, int G) {
    const int tid = tid_(), wid = tid >> 6, lane = tid & 63;
    const float* LOGITS = (const float*)(p.ws + OFF_LOGITS); int* cnt = (int*)(p.ws + OFF_CTL) + (PROBE ? 8192 : 0);
    int* EIDX = (int*)(p.ws + (PROBE ? OFF_PROJ + 40 * MiB : OFF_EIDX)); int* POSI = (int*)(p.ws + (PROBE ? OFF_PROJ + 41 * MiB : OFF_POSI)); int* TOKL = (int*)(p.ws + (PROBE ? OFF_PROJ : OFF_TOKL)); float* WL = (float*)(p.ws + (PROBE ? OFF_PROJ + 16 * MiB : OFF_WL));
    const f32x4 bias = *(const f32x4*)(p.router_bias + 4 * lane);
    int pt = -1, pE = 0, ppos = 0; float pw = 0.f;
    const int tstart = bid * 8 + wid, tstep = G * 8;
    f32x4 lgn = {0.f, 0.f, 0.f, 0.f};
    if (tstart < T_) lgn = *(const f32x4*)(LOGITS + (size_t)tstart * 256 + 4 * lane);
#pragma unroll 1
    for (int t = tstart; t < T_; t += tstep) {
        const f32x4 lg = lgn;
        if (t + tstep < T_) lgn = *(const f32x4*)(LOGITS + (size_t)(t + tstep) * 256 + 4 * lane);
        float sc[4], bv[4];
#pragma unroll
        for (int i = 0; i < 4; ++i) { sc[i] = sigmoidf_(lg[i]); bv[i] = sc[i] + bias[i]; }
        float m1 = fmaxf(bv[0], bv[1]), m2 = fminf(bv[0], bv[1]);
#pragma unroll
        for (int i = 2; i < 4; ++i) { const float a = bv[i]; m2 = fmaxf(m2, fminf(m1, a)); m1 = fmaxf(m1, a); }
        { float b1 = dppf_<0xB1>(m1), b2 = dppf_<0xB1>(m2); m2 = fmaxf(fminf(m1, b1), fmaxf(m2, b2)); m1 = fmaxf(m1, b1);
          b1 = dppf_<0x4E>(m1); b2 = dppf_<0x4E>(m2); m2 = fmaxf(fminf(m1, b1), fmaxf(m2, b2)); m1 = fmaxf(m1, b1);
          b1 = dppf_<0x141>(m1); b2 = dppf_<0x141>(m2); m2 = fmaxf(fminf(m1, b1), fmaxf(m2, b2)); m1 = fmaxf(m1, b1); }
        const float gs = m1 + m2; const int grp = lane >> 3; int rank = 0;
#pragma unroll
        for (int g2 = 0; g2 < 8; ++g2) { const float og = __int_as_float(__builtin_amdgcn_readlane(__float_as_int(gs), 8 * g2)); rank += (og > gs || (og == gs && g2 < grp)) ? 1 : 0; }
        const bool sel = rank < 4;
        float v[4];
#pragma unroll
        for (int i = 0; i < 4; ++i) v[i] = sel ? bv[i] : -INFINITY;
        int myE = 0; float myS = 0.f; float ssum = 0.f;
#pragma unroll
        for (int k = 0; k < 8; ++k) {
            float lm = v[0]; int li = 0;
#pragma unroll
            for (int i = 1; i < 4; ++i) if (v[i] > lm) { lm = v[i]; li = i; }
            float r = fmaxf(lm, dppf_<0xB1>(lm)); r = fmaxf(r, dppf_<0x4E>(r)); r = fmaxf(r, dppf_<0x141>(r)); r = fmaxf(r, dppf_<0x140>(r));
            const float r0 = __int_as_float(__builtin_amdgcn_readlane(__float_as_int(r), 0)), r1 = __int_as_float(__builtin_amdgcn_readlane(__float_as_int(r), 16));
            const float r2 = __int_as_float(__builtin_amdgcn_readlane(__float_as_int(r), 32)), r3 = __int_as_float(__builtin_amdgcn_readlane(__float_as_int(r), 48));
            const float gm = fmaxf(fmaxf(r0, r1), fmaxf(r2, r3));
            const unsigned long long bal = __builtin_amdgcn_ballot_w64(lm == gm);
            const int owner = (int)__builtin_ctzll(bal);
            const float ls = li == 0 ? sc[0] : (li == 1 ? sc[1] : (li == 2 ? sc[2] : sc[3]));
            const float sv = __int_as_float(__builtin_amdgcn_readlane(__float_as_int(ls), owner));
            const int wi = __builtin_amdgcn_readlane(li, owner);
            const int be = 4 * owner + wi;
            if (lane == owner) {
#pragma unroll
                for (int i = 0; i < 4; ++i) if (i == wi) v[i] = -INFINITY;
            }
            ssum += sv;
            if (lane == k) { myE = be; myS = sv; }
        }
        if (lane < 8 && pt >= 0) { const size_t li_ = (size_t)pE * T_ + (size_t)((pt >> 3) & 7) * (T_ / 8) + ppos; TOKL[li_] = pt; WL[li_] = pw; EIDX[pt * 8 + lane] = pE; POSI[pt * 8 + lane] = ppos; }
        pt = t; pE = myE; pw = myS / ssum * 2.5f;
        if (lane < 8) ppos = atomicAdd(cnt + myE * 8 + ((t >> 3) & 7), 1);
    }
    if (lane < 8 && pt >= 0) { const size_t li_ = (size_t)pE * T_ + (size_t)((pt >> 3) & 7) * (T_ / 8) + ppos; TOKL[li_] = pt; WL[li_] = pw; EIDX[pt * 8 + lane] = pE; POSI[pt * 8 + lane] = ppos; }
}

#define XB_TMO      128
#define XB_XCNT(j)  (256  + 64 * (j))
#define XB_XSUB(j)  (1280 + 64 * (j))
#define XB_XGEN(j)  (2304 + 64 * (j))
#define XB_TOP      3328
#define XB_TOPGEN   3392
#define XCD_BAR_WORDS 3456
#define XB_SPIN_CAP (1u << 18)

__device__ __forceinline__ unsigned xb_ld(unsigned* p)              { return __hip_atomic_load(p, __ATOMIC_RELAXED, __HIP_MEMORY_SCOPE_AGENT); }
__device__ __forceinline__ unsigned xb_add(unsigned* p, unsigned v) { return __hip_atomic_fetch_add(p, v, __ATOMIC_RELAXED, __HIP_MEMORY_SCOPE_AGENT); }
__device__ __forceinline__ unsigned xb_xcc_id() { return (unsigned)__builtin_amdgcn_s_getreg((3 << 11) | 20) & 0xFu; }
#define XB_SPIN(cond, bar) do { unsigned _sp = 0; while (cond) { __builtin_amdgcn_s_sleep(1); \
    if ((++_sp & 255u) == 0u) { if (xb_ld(&(bar)[XB_TMO])) break; if (_sp > XB_SPIN_CAP) { atomicAdd(&(bar)[XB_TMO], 1u); break; } } } } while (0)

struct XcdBarrier {
    unsigned* bar; unsigned x;
    volatile LAS unsigned* st;
};

__device__ __forceinline__ XcdBarrier xcd_barrier_post(unsigned* bar, volatile LAS unsigned* st) {
    XcdBarrier b; b.bar = bar; b.x = xb_xcc_id(); b.st = st;
    if (threadIdx.x == 0) (void)xb_add(&bar[XB_XCNT(b.x)], 1u);
    return b;
}
__device__ __forceinline__ void xcd_barrier_complete(unsigned* bar, unsigned x, unsigned& nloc, unsigned& nx) {
    const unsigned G = gridDim.x * gridDim.y * gridDim.z;
    unsigned sum, cnt, mine, sp = 0u;
    for (;;) {
        sum = 0u; cnt = 0u; mine = 0u;
#pragma unroll
        for (unsigned j = 0; j < 16; ++j) { const unsigned c = xb_ld(&bar[XB_XCNT(j)]); sum += c; cnt += (c > 0u) ? 1u : 0u; mine = (j == x) ? c : mine; }
        if (sum == G) break;
        __builtin_amdgcn_s_sleep(1);
        if ((++sp & 255u) == 0u) { if (xb_ld(&bar[XB_TMO])) break; if (sp > XB_SPIN_CAP) { atomicAdd(&bar[XB_TMO], 1u); break; } }
    }
    nloc = mine > 0u ? mine : 1u; nx = cnt > 0u ? cnt : 1u;
}

__device__ __forceinline__ void xcd_barrier(const XcdBarrier& b) {
    asm volatile("s_waitcnt vmcnt(0)" ::: "memory");
    __syncthreads();
    if (threadIdx.x == 0) {
        unsigned* bar = b.bar;
        __builtin_amdgcn_s_waitcnt(0);
        unsigned nloc = b.st[0], nx = b.st[1];
        if (nloc == 0u) { xcd_barrier_complete(bar, b.x, nloc, nx); b.st[0] = nloc; b.st[1] = nx; }
        const unsigned old = xb_add(&bar[XB_XSUB(b.x)], 1u);
        const unsigned gen = old / nloc;
        if (old + 1u == (gen + 1u) * nloc) {
            __builtin_amdgcn_fence(__ATOMIC_RELEASE, "agent");
            asm volatile("s_waitcnt vmcnt(0)" ::: "memory");
            const unsigned og = xb_add(&bar[XB_TOP], 1u);
            const unsigned tg = og / nx;
            if (og + 1u == (tg + 1u) * nx) xb_add(&bar[XB_TOPGEN], 1u);
            else XB_SPIN(xb_ld(&bar[XB_TOPGEN]) == tg, bar);
            __builtin_amdgcn_fence(__ATOMIC_ACQUIRE, "agent");
            xb_add(&bar[XB_XGEN(b.x)], 1u);
            asm volatile("s_waitcnt vmcnt(0)" ::: "memory");
        } else {
            XB_SPIN(xb_ld(&bar[XB_XGEN(b.x)]) == gen, bar);
            __builtin_amdgcn_fence(__ATOMIC_ACQUIRE, "agent");
            asm volatile("s_waitcnt vmcnt(0)" ::: "memory");
        }
    }
    __syncthreads();
}

constexpr size_t OFF_BAR = 16 << 10;
struct RowGather { const int* tokl; int pos0, cnt; __device__ __forceinline__ unsigned operator()(int r) const { int pos = pos0 + r; pos = pos < cnt ? pos : cnt - 1; return (unsigned)tokl[pos] * 1024u; } };
struct RowSlots { int base, pos0, cnt; __device__ __forceinline__ unsigned operator()(int r) const { int pos = pos0 + r; pos = pos < cnt ? pos : cnt - 1; return (unsigned)(base + pos) * 256u; } };

__device__ __forceinline__ void ph_norm1(const P& p, int bid, int G) { const float* mod = (const float*)(p.ws + OFF_MOD); phase_norm(p.x, p.norm1_g, mod + 1024, mod, (bf16_t*)(p.ws + OFF_H), p.ws + OFF_H2F8, bid, G); }
__device__ __forceinline__ void ph_inproj(const P& p, unsigned char* smem, int bid, int G) {
    EpiStoreBf16 E{(bf16_t*)(p.ws + OFF_PROJ), NPROJ};
    pg8::Gemm g{(const bf16_t*)(p.ws + OFF_H2F8), (const bf16_t*)(p.ws + OFF_WINT), T_, NPROJ, 512}; pg8::StaticOrder S; S.init(T_, NPROJ, G, bid);
    pg8::gemm_phase<EpiStoreBf16, pg8::StaticOrder, false, true, true>((PG8_LAS unsigned char*)smem, g, S, E);
}
__device__ __forceinline__ void ph_prep(const P& p, unsigned char* smem, int bid, int G) {
#pragma unroll 1
    for (int n = bid; n < 256; n += G) prep_chunk(p, n, smem);
}
template <bool FINAL> __device__ __forceinline__ void ph_gla(const P& p, unsigned char* smem, int bid, int G) {
#pragma unroll 1
    for (int u = bid; u < 256; u += G) gla_unit<FINAL>(p, u >> 2, u & 3, smem);
}
template <int AV>
__device__ __forceinline__ void ph_att(const P& p, unsigned char* smem, int bid, int G) {
#pragma unroll 1
    for (int uu = bid * 2; uu < 512; uu += (uu & 1) ? 2 * G - 1 : 1) { const int u = uu >> 1, h = u & 7, j = u >> 3; attn_unit<AV>(p, h, (uu & 1) ? 63 - j : j, smem); }
}
__device__ __forceinline__ void ph_b1(const P& p, unsigned char* smem, int bid, int G) {
    const bf16_t* PROJ = (const bf16_t*)(p.ws + OFF_PROJ);
    bf16_t* M1 = (bf16_t*)(p.ws + OFF_H);
    EpiB1a Ea{M1, PROJ}; EpiB1b Eb{M1, PROJ, (bf16_t*)(p.ws + OFF_MERGED)};
    pg8::StaticOrder S; S.init(T_, D_, G, bid);
    { pg8::Gemm g{(const bf16_t*)(p.ws + OFF_OGLA), (const bf16_t*)(p.ws + OFF_WBG), T_, D_, 512};
      pg8::gemm_phase<EpiB1a, pg8::StaticOrder, true, true, true>((PG8_LAS unsigned char*)smem, g, S, Ea); }
    __threadfence_block();
    { pg8::Gemm g{(const bf16_t*)(p.ws + OFF_ODIFF), (const bf16_t*)(p.ws + OFF_WBD), T_, D_, 512};
      pg8::gemm_phase<EpiB1b, pg8::StaticOrder, true, true, true>((PG8_LAS unsigned char*)smem, g, S, Eb); }
}
__device__ __forceinline__ void ph_b2(const P& p, unsigned char* smem, int bid, int G) {
    const float* mod = (const float*)(p.ws + OFF_MOD); EpiB2 E{p.x, mod + 2048, p.out};
    pg8::Gemm g{(const bf16_t*)(p.ws + OFF_MERGED), (const bf16_t*)(p.ws + OFF_WO), T_, D_, 512}; pg8::StaticOrder S; S.init(T_, D_, G, bid);
    pg8::gemm_phase<EpiB2, pg8::StaticOrder, true, true, true>((PG8_LAS unsigned char*)smem, g, S, E);
}
__device__ __forceinline__ void ph_norm2(const P& p, int bid, int G) { const float* mod = (const float*)(p.ws + OFF_MOD); phase_norm(p.out, p.norm2_g, mod + 4096, mod + 3072, (bf16_t*)(p.ws + OFF_H), p.ws + OFF_H2F8, bid, G); }
__device__ __forceinline__ void ph_f1(const P& p, unsigned char* smem, int bid, int G) {
    EpiF1 E{(float*)(p.ws + OFF_LOGITS), (bf16_t*)(p.ws + OFF_HS)};
    pg8::Gemm g{(const bf16_t*)(p.ws + OFF_H), (const bf16_t*)(p.ws + OFF_WF), T_, 768, 1024}; pg8::StaticOrder S; S.init(T_, 768, G, bid);
    pg8::gemm_phase<EpiF1, pg8::StaticOrder, true, true>((PG8_LAS unsigned char*)smem, g, S, E);
}
__device__ __forceinline__ void ph_route(const P& p, unsigned char* smem, int bid, int G) {
#ifndef RTP
#define RTP 0
#endif
    if (RTP) { phase_route<true>(p, bid, G); __syncthreads(); }
    phase_route<false>(p, bid, G);
    EpiStoreBf16 E{(bf16_t*)(p.ws + OFF_SD), D_};
    pg8::Gemm g{(const bf16_t*)(p.ws + OFF_HS), (const bf16_t*)(p.ws + OFF_WSD), T_, D_, 256}; pg8::StaticOrder S; S.init(T_, D_, G, bid);
#ifndef SDP
#define SDP 0
#endif
    pg8::gemm_phase<EpiStoreBf16, pg8::StaticOrder, true, true>((PG8_LAS unsigned char*)smem, g, S, E);
    if (SDP) { __syncthreads(); pg8::gemm_phase<EpiStoreBf16, pg8::StaticOrder, true, true>((PG8_LAS unsigned char*)smem, g, S, E); }
}
typedef short s16x4 __attribute__((ext_vector_type(4)));
__device__ __forceinline__ s16x4 ds_tr16(LAS const unsigned char* pp) { return __builtin_bit_cast(s16x4, __builtin_amdgcn_ds_read_tr16_b64_v4i16((LAS s16x4*)pp)); }
__device__ __forceinline__ void glds16_asm(const void* gsrc, unsigned lds_dst) { unsigned keep;
    asm volatile("s_mov_b32 %0, m0\n\ts_mov_b32 m0, %2\n\ts_nop 0\n\tglobal_load_lds_dwordx4 %1, off\n\ts_mov_b32 m0, %0" : "=&s"(keep) : "v"(gsrc), "s"(lds_dst) : "memory"); }
#ifndef MOE_NSL
#define MOE_NSL 2
#endif
constexpr int MOE_RING = 32768, MOE_BT = 3 * MOE_RING;
#ifndef XV
#define XV 0
#endif
__device__ __forceinline__ int list_idx(const int* so8, int r) { int sub = 0, off = 0; LAS const int* q8 = (LAS const int*)so8;
#pragma unroll
    for (int q = 1; q < 8; ++q) { const int o = q8[q]; if (r >= o) { sub = q; off = o; } }
    return sub * (T_ / 8) + (r - off); }
template <int MODE, int NA, int XVV = 0>
__device__ __forceinline__ void moe_pass(const P& p, unsigned char* smem, int e, int s, int cnt, int cstart, int row0, const int* so8) {
    constexpr int K = MODE == 0 ? 1024 : 256, NK = K / 64, BLD = MODE == 0 ? 256 : 1024;
    constexpr int NSL = MODE == 1 ? MOE_NSL : 1, NKT = NK * NSL;
    const int tid = tid_(), lane = tid & 63, fr = lane & 15, fq = lane >> 4; const int wid = __builtin_amdgcn_readfirstlane(tid >> 6);
    LAS unsigned char* lds = (LAS unsigned char*)smem; const unsigned lds0 = (unsigned)(uintptr_t)smem;
    const float* gsrc;
    { const int dk = tid >> 5, c4 = tid & 31;
      if (MODE == 0) gsrc = (c4 < 16 ? p.w_eg : p.w_eu) + (size_t)e * 1024 * 256 + (size_t)dk * 256 + 64 * s + 4 * (c4 & 15);
      else gsrc = p.w_ed + (size_t)e * 256 * 1024 + (size_t)dk * 1024 + 128 * (NSL * s) + 4 * c4; }
    constexpr int BLDX = XVV == 3 ? 0 : BLD; if (XVV == 3) gsrc = p.w_eg + 4 * (tid & 31);
    const int kr = tid >> 3, seg = tid & 7;
    const unsigned roff = (unsigned)kr * 512u + (unsigned)seg * 64u;
    unsigned woff[4];
    { const unsigned fk = (unsigned)((kr & 3) | (((kr >> 3) & 1) << 2)); const int gi = seg >> 1, hh = seg & 1;
#pragma unroll
      for (int q4 = 0; q4 < 4; ++q4) woff[q4] = (unsigned)MOE_BT + (unsigned)kr * 256u + ((((unsigned)(2 * gi + (q4 & 1))) ^ fk) << 5) + 8u * (unsigned)(2 * hh + (q4 >> 1)); }
    const int G4 = lane >> 4, q = (lane & 15) >> 2, pp = lane & 3;
    const unsigned LX = (unsigned)MOE_BT + (unsigned)(8 * G4 + q) * 256u + 8u * (unsigned)pp + ((unsigned)(q | ((G4 & 1) << 2)) << 5);
    const unsigned char* A = MODE == 0 ? (const unsigned char*)(p.ws + OFF_H2F8) : (const unsigned char*)(p.ws + OFF_HE);
    unsigned aoff[4];
    { const int* tokl = (const int*)(p.ws + OFF_TOKL) + (size_t)e * T_;
#pragma unroll
      for (int j = 0; j < 4; ++j) { int pos = row0 + 16 * (wid + 8 * j) + fr; pos = pos < cnt ? pos : cnt - 1;
          aoff[j] = MODE == 0 ? (unsigned)tokl[list_idx(so8, pos)] * 1024u + 8u * fq : (unsigned)(cstart + pos) * 256u + 8u * fq; } }
    constexpr int NA1 = NA > 0 ? NA : 1;
    f32x4 acc[NA1][8];
#pragma unroll
    for (int j = 0; j < NA1; ++j)
#pragma unroll
        for (int n = 0; n < 8; ++n) acc[j][n] = (f32x4){0.f, 0.f, 0.f, 0.f};
    u32x2 A0[NA1], A1[NA1];
#define MOE_DMA(t, slot) do { _Pragma("unroll") for (int j_ = 0; j_ < 4; ++j_) \
        glds16_asm(gsrc + (MODE == 1 ? (size_t)((t) >> 2) * 128 + ((size_t)((t) & 3) * 64 + 16 * j_) * BLDX : ((size_t)(t) * 64 + 16 * j_) * BLDX), (unsigned)__builtin_amdgcn_readfirstlane(lds0 + (unsigned)(slot) * MOE_RING + (512 * j_ + 64 * wid) * 16)); } while (0)
#define MOE_CONVERT(slot, bo) do { f32x4 br_[4]; _Pragma("unroll") for (int q4_ = 0; q4_ < 4; ++q4_) br_[q4_] = *(LAS const f32x4*)(lds + (slot) * MOE_RING + roff + 16 * q4_); \
        _Pragma("unroll") for (int q4_ = 0; q4_ < 4; ++q4_) { const u32x2 w_ = {pk2(br_[q4_][0], br_[q4_][1]), pk2(br_[q4_][2], br_[q4_][3])}; *(LAS u32x2*)(lds + (bo) + woff[q4_]) = w_; } } while (0)
#define MOE_LOADA0(AX, t, kk) do { if (NA > 0) { _Pragma("unroll") for (int j_ = 0; j_ < NA1; ++j_) { const unsigned vo_ = aoff[j_] + (unsigned)(MODE == 1 ? ((t) & 3) : (t)) * 64u; \
        asm volatile("s_nop 4\n\tglobal_load_dwordx2 %0, %1, %2 offset:%3" : "=v"(AX[j_]) : "v"(vo_), "s"(A), "i"(32 * (kk)) : "memory"); } } } while (0)
#define MOE_LOADA(AX, t, kk) do { if (NA > 0) { _Pragma("unroll") for (int j_ = 0; j_ < NA1; ++j_) { const unsigned vo_ = aoff[j_] + (unsigned)(MODE == 1 ? ((t) & 3) : (t)) * 64u; \
        asm volatile("s_nop 4\n\tglobal_load_dwordx2 %0, %1, %2 offset:%3" : "+v"(AX[j_]) : "v"(vo_), "s"(A), "i"(32 * (kk)) : "memory"); } } } while (0)
#define MOE_WAITA(AX, n) do { if (NA == 4) asm volatile("s_waitcnt vmcnt(%4)" : "+v"(AX[0]), "+v"(AX[NA1 > 1 ? 1 : 0]), "+v"(AX[NA1 > 2 ? 2 : 0]), "+v"(AX[NA1 > 3 ? 3 : 0]) : "i"(n) : "memory"); \
        else if (NA == 3) asm volatile("s_waitcnt vmcnt(%3)" : "+v"(AX[0]), "+v"(AX[NA1 > 1 ? 1 : 0]), "+v"(AX[NA1 > 2 ? 2 : 0]) : "i"(n) : "memory"); \
        else if (NA == 2) asm volatile("s_waitcnt vmcnt(%2)" : "+v"(AX[0]), "+v"(AX[NA1 > 1 ? 1 : 0]) : "i"(n) : "memory"); \
        else if (NA == 1) asm volatile("s_waitcnt vmcnt(%1)" : "+v"(AX[0]) : "i"(n) : "memory"); } while (0)
#define MOE_COMPUTE(AX, bo, kk) do { if (NA > 0) { bf16x8 aw_[NA1]; _Pragma("unroll") for (int j_ = 0; j_ < NA1; ++j_) aw_[j_] = fp8x8_to_bf16x8(AX[j_]); _Pragma("unroll") for (int n_ = 0; n_ < 8; ++n_) { \
        LAS const unsigned char* bp_ = lds + (bo) + (LX ^ (unsigned)(n_ << 5)) + (kk) * 8192; \
        const s16x4 t0_ = ds_tr16(bp_), t1_ = ds_tr16(bp_ + 1024); \
        const bf16x8 bf_ = {t0_[0], t0_[1], t0_[2], t0_[3], t1_[0], t1_[1], t1_[2], t1_[3]}; \
        _Pragma("unroll") for (int j_ = 0; j_ < NA1; ++j_) acc[j_][n_] = MFMA16(bf_, aw_[j_], acc[j_][n_]); } } } while (0)
#define MOE_BAR() __builtin_amdgcn_s_barrier()
    MOE_DMA(0, 0); MOE_DMA(1, 1);
    MOE_LOADA0(A0, 0, 0); MOE_LOADA0(A1, 0, 1);
    asm volatile("s_waitcnt vmcnt(0)" ::: "memory");
    MOE_BAR();
    MOE_CONVERT(0, 0);
    asm volatile("s_waitcnt lgkmcnt(0)" ::: "memory");
    MOE_BAR();
    int slot1 = 1, slot2 = 2;
#pragma unroll 1
    for (int sl = 0; sl < NSL; ++sl) {
#pragma unroll 1
    for (int tt = 0; tt < NK; ++tt) {
        const int t = sl * NK + tt;
        const unsigned bo = (unsigned)(t & 1) * 16384u;
        const int t1 = t + 1 < NKT ? t + 1 : NKT - 1, t2 = t + 2 < NKT ? t + 2 : NKT - 1;
        MOE_DMA(t2, slot2);
        MOE_WAITA(A0, NA + 4);
        MOE_COMPUTE(A0, bo, 0);
        MOE_WAITA(A1, 4);
        if (NA == 0) asm volatile("s_waitcnt vmcnt(4)" ::: "memory");
        MOE_BAR();
        MOE_LOADA(A0, t1, 0); MOE_CONVERT(slot1, bo ^ 16384u);
        MOE_COMPUTE(A1, bo, 1);
        MOE_LOADA(A1, t1, 1);
        asm volatile("s_waitcnt lgkmcnt(0)" ::: "memory");
        MOE_BAR();
        slot1 = slot2; slot2 = slot2 == 2 ? 0 : slot2 + 1;
    }
    MOE_WAITA(A0, 0); MOE_WAITA(A1, 0);
    if (NA == 0) asm volatile("s_waitcnt vmcnt(0)" ::: "memory");
    if (NA > 0) {
        const int tid2 = tid_(), fr2 = tid2 & 15, fq2 = (tid2 & 63) >> 4; const int wid2 = __builtin_amdgcn_readfirstlane(tid2 >> 6);
#pragma unroll
        for (int j = 0; j < NA1; ++j) {
            const int pos = row0 + 16 * (wid2 + 8 * j) + fr2;
            if (pos < cnt) {
                if (MODE == 0) {
                    unsigned char* orow = p.ws + OFF_HE + (size_t)(cstart + pos) * 256 + 64 * s + 8 * fq2;
#pragma unroll
                    for (int g = 0; g < 2; ++g) {
                        float h[8];
#pragma unroll
                        for (int b = 0; b < 2; ++b)
#pragma unroll
                            for (int i = 0; i < 4; ++i) h[4 * b + i] = siluf_(acc[j][2 * g + b][i]) * acc[j][4 + 2 * g + b][i];
                        *(u32x2*)(orow + 32 * g) = (u32x2){pk4_fp8(h[0], h[1], h[2], h[3]), pk4_fp8(h[4], h[5], h[6], h[7])};
                    }
                } else {
                    const float wt = ((const float*)(p.ws + OFF_WL))[(size_t)e * T_ + list_idx(so8, pos)];
                    unsigned char* orow = p.ws + OFF_YS + (size_t)(cstart + pos) * D_ + 128 * (NSL * s + sl) + 8 * fq2;
#pragma unroll
                    for (int g = 0; g < 4; ++g) {
                        const f32x4 v0 = acc[j][2 * g] * wt, v1 = acc[j][2 * g + 1] * wt;
                        *(u32x2*)(orow + 32 * g) = (u32x2){pk4_fp8(v0[0], v0[1], v0[2], v0[3]), pk4_fp8(v1[0], v1[1], v1[2], v1[3])};
                    }
                }
            }
        }
    }
    if (sl + 1 < NSL) {
#pragma unroll
        for (int j = 0; j < NA1; ++j)
#pragma unroll
            for (int n = 0; n < 8; ++n) acc[j][n] = (f32x4){0.f, 0.f, 0.f, 0.f};
    }
    }
#undef MOE_DMA
#undef MOE_CONVERT
#undef MOE_LOADA
#undef MOE_LOADA0
#undef MOE_WAITA
#undef MOE_COMPUTE
#undef MOE_BAR
}
template <int MODE, int XVV = 0>
__device__ __forceinline__ void moe_unit_pass(const P& p, int e, int s, int cnt, int cstart, int row0, unsigned char* smem, const int* so8) {
    const int wid = __builtin_amdgcn_readfirstlane(tid_() >> 6);
    const int nrows = (cnt - row0) < 512 ? (cnt - row0) : 512, ntile = (nrows + 15) >> 4;
    const int nact = ntile > wid ? (ntile - wid + 7) >> 3 : 0;
    if (nact == 4) moe_pass<MODE, 4, XVV>(p, smem, e, s, cnt, cstart, row0, so8);
    else if (nact == 3) moe_pass<MODE, 3, XVV>(p, smem, e, s, cnt, cstart, row0, so8);
    else if (nact == 2) moe_pass<MODE, 2, XVV>(p, smem, e, s, cnt, cstart, row0, so8);
    else if (nact == 1) moe_pass<MODE, 1, XVV>(p, smem, e, s, cnt, cstart, row0, so8);
    else moe_pass<MODE, 0, XVV>(p, smem, e, s, cnt, cstart, row0, so8);
}
template <int MODE, int XVV = 0>
__device__ __forceinline__ void ph_moe(const P& p, unsigned char* smem, int bid, int G) {
    int* cs = (int*)smem;
    const int* cnt = (const int*)(p.ws + OFF_CTL);
    __syncthreads();
    if (threadIdx.x < 256) { const int e = threadIdx.x; int a = 0;
#pragma unroll
        for (int q = 0; q < 8; ++q) { cs[1024 + 8 * e + q] = a; a += cnt[8 * e + q]; }
        cs[e] = a; }
    __syncthreads();
    if (threadIdx.x == 0) { int a = 0, mx = 0; for (int e = 0; e < 256; ++e) { const int c = cs[e]; cs[256 + e] = a; a += c; mx = c > mx ? c : mx; } cs[512] = mx; }
    __syncthreads();
    constexpr int NS = MODE == 0 ? 4 : 8 / MOE_NSL, NU1 = 256 * NS;
    const int NU = ((cs[512] + 511) >> 9) * NU1;
    unsigned* qctr = (unsigned*)(p.ws + OFF_CTL) + 2560 + MODE + (XVV ? 2 : 0);
    int u = bid;
#pragma unroll 1
    while (u < NU) {
        const int pass = u / NU1, r = u - pass * NU1;
        int e, s;
        if ((G & 63) == 0 && r < (NU1 / G) * G) { const int x = r & 7, y = (r >> 3) % (G >> 3), rnd = r / G; s = y % NS; e = rnd * (G / NS) + x * (G / (8 * NS)) + y / NS; }
        else { e = r / NS; s = r % NS; }
        const int c = cs[e], c0 = cs[256 + e];
        const bool pre = u + 2 * G < NU; int nxt = 0;
        if (pre && threadIdx.x == 0) nxt = G + (int)__hip_atomic_fetch_add(qctr, 1u, __ATOMIC_RELAXED, __HIP_MEMORY_SCOPE_AGENT);
        if (c > pass * 512) moe_unit_pass<MODE, XVV>(p, e, s, c, c0, pass * 512, smem + 12288, cs + 1024 + 8 * e);
        __syncthreads();
        if (threadIdx.x == 0) cs[513] = pre ? nxt : G + (int)__hip_atomic_fetch_add(qctr, 1u, __ATOMIC_RELAXED, __HIP_MEMORY_SCOPE_AGENT);
        __syncthreads();
        u = cs[513];
    }
}
template <bool PROBE = false>
__device__ __forceinline__ void ph_comb(const P& p, unsigned char* smem, int bid, int G) {
    int* cs = (int*)smem;
    const int* cnt = (const int*)(p.ws + OFF_CTL);
    __syncthreads();
    if (threadIdx.x < 256) { const int e = threadIdx.x; int a = 0;
#pragma unroll
        for (int q = 0; q < 8; ++q) { cs[256 + 8 * e + q] = a; a += cnt[8 * e + q]; }
        cs[e] = a; }
    __syncthreads();
    if (threadIdx.x == 0) { int a = 0; for (int e = 0; e < 256; ++e) { const int c = cs[e]; cs[e] = a; a += c; } }
    __syncthreads();
    if (threadIdx.x < 256) { const int e = threadIdx.x, c0 = cs[e];
#pragma unroll
        for (int q = 0; q < 8; ++q) cs[256 + 8 * e + q] += c0; }
    __syncthreads();
    const int tid = tid_(), wid = tid >> 6, lane = tid & 63;
    const float* gate = (const float*)(p.ws + OFF_MOD) + 5120; const bf16_t* SD = (const bf16_t*)(p.ws + OFF_SD); const unsigned char* YS = p.ws + OFF_YS;
    const int* EIDX = (const int*)(p.ws + OFF_EIDX); const int* POSI = (const int*)(p.ws + OFF_POSI);
    const int t0 = bid * 8 + wid, tstep = G * 8;
#pragma unroll 1
    for (int tb = t0; tb < T_; tb += 8 * tstep) {
        const int tl = tb + tstep * (lane >> 3);
        int slotv = 0;
        if (tl < T_) slotv = cs[256 + 8 * EIDX[tl * 8 + (lane & 7)] + ((tl >> 3) & 7)] + POSI[tl * 8 + (lane & 7)];
        u32x2 y[2][2][8]; u32x4 sd[2][2];
#define COMB_LOAD(i, b) do { const int t_ = tb + tstep * (i); if (t_ < T_) { _Pragma("unroll") for (int k_ = 0; k_ < 8; ++k_) { const int sl_ = __builtin_amdgcn_readlane(slotv, 8 * (i) + k_); \
            const unsigned char* yr_ = YS + (size_t)sl_ * D_ + 8 * lane; y[b][0][k_] = *(const u32x2*)yr_; y[b][1][k_] = *(const u32x2*)(yr_ + 512); } \
            sd[b][0] = *(const u32x4*)(SD + (size_t)t_ * D_ + 8 * lane); sd[b][1] = *(const u32x4*)(SD + (size_t)t_ * D_ + 512 + 8 * lane); } } while (0)
#define COMB_ACC(i, b) do { const int t_ = tb + tstep * (i); if (t_ < T_) { _Pragma("unroll") for (int j_ = 0; j_ < 2; ++j_) { const int c_ = 512 * j_ + 8 * lane; float a_[8]; \
            _Pragma("unroll") for (int q_ = 0; q_ < 4; ++q_) { a_[2 * q_] = bflo(sd[b][j_][q_]); a_[2 * q_ + 1] = bfhi(sd[b][j_][q_]); } \
            _Pragma("unroll") for (int k_ = 0; k_ < 8; ++k_) { _Pragma("unroll") for (int q_ = 0; q_ < 2; ++q_) { \
                const f32x2v lo_ = __builtin_amdgcn_cvt_pk_f32_fp8((int)y[b][j_][k_][q_], false), hi_ = __builtin_amdgcn_cvt_pk_f32_fp8((int)y[b][j_][k_][q_], true); \
                a_[4 * q_] += lo_[0]; a_[4 * q_ + 1] += lo_[1]; a_[4 * q_ + 2] += hi_[0]; a_[4 * q_ + 3] += hi_[1]; } } \
            float* o_ = p.out + (size_t)t_ * D_ + c_; float* w_ = PROBE ? (float*)(p.ws + OFF_OGLA) + (size_t)t_ * D_ + c_ : o_; \
            const f32x4 x0_ = *(const f32x4*)o_, x1_ = *(const f32x4*)(o_ + 4), g0_ = *(const f32x4*)(gate + c_), g1_ = *(const f32x4*)(gate + c_ + 4); \
            *(f32x4*)w_ = x0_ + g0_ * (f32x4){a_[0], a_[1], a_[2], a_[3]}; *(f32x4*)(w_ + 4) = x1_ + g1_ * (f32x4){a_[4], a_[5], a_[6], a_[7]}; } } } while (0)
        COMB_LOAD(0, 0);
#pragma unroll
        for (int i = 0; i < 8; i += 2) {
            COMB_LOAD(i + 1, 1); COMB_ACC(i, 0);
            if (i + 2 < 8) COMB_LOAD(i + 2, 0);
            COMB_ACC(i + 1, 1);
        }
#undef COMB_LOAD
#undef COMB_ACC
    }
}

extern __shared__ __attribute__((aligned(16))) unsigned char smem_dyn[];
#ifndef MK_FUSED
#define MK_FUSED 1
#endif
constexpr int LDS_BYTES = 142 * 1024;

#if MK_FUSED
__global__ void __launch_bounds__(NTHR, 2) k_fused(P p) {
    unsigned char* smem = smem_dyn + 64;
    if (threadIdx.x == 0) *(u32x4*)smem_dyn = (u32x4){0u, 0u, 0u, 0u};
    __syncthreads();
    XcdBarrier bar = xcd_barrier_post((unsigned*)(p.ws + OFF_BAR), (volatile LAS unsigned*)smem_dyn);
    const int bid = blockIdx.x, G = gridDim.x;
#ifndef DUP
#define DUP 0
#endif
#define RUN(bit, call) do { call; if (DUP & (1 << (bit))) { __syncthreads(); call; } } while (0)
    RUN(0, phase_p0(p, smem, bid, G));            xcd_barrier(bar);
    RUN(1, ph_norm1(p, bid, G)); phase_conv(p, smem, bid, G, 0, NT_WIN);                  xcd_barrier(bar);
    RUN(2, ph_inproj(p, smem, bid, G));           xcd_barrier(bar);
    RUN(11, ph_prep(p, smem, bid, G));            xcd_barrier(bar);
    RUN(8, ph_gla<false>(p, smem, bid, G));       xcd_barrier(bar);
    RUN(9, phase_g2(p, bid, G)); phase_conv(p, smem, bid, G, NT_WIN, NT_ALL);                  xcd_barrier(bar);
    RUN(10, ph_gla<true>(p, smem, bid, G));
#ifndef ATTP
#define ATTP 0
#endif
    if (ATTP) { ph_att<ATTP>(p, smem, bid, G); __syncthreads(); }
    RUN(4, ph_att<0>(p, smem, bid, G));           xcd_barrier(bar);
    RUN(5, ph_b1(p, smem, bid, G));               xcd_barrier(bar);
    RUN(5, ph_b2(p, smem, bid, G));               xcd_barrier(bar);
    RUN(1, ph_norm2(p, bid, G));                  xcd_barrier(bar);
    RUN(5, ph_f1(p, smem, bid, G));               xcd_barrier(bar);
    ph_route(p, smem, bid, G);                    xcd_barrier(bar);
#ifndef MOEP
#define MOEP 0
#endif
    if (MOEP & 1) { ph_moe<0, (XV ? XV : 4)>(p, smem, bid, G); __syncthreads(); }
    ph_moe<0>(p, smem, bid, G);                   xcd_barrier(bar);
    if (MOEP & 2) { ph_moe<1, (XV ? XV : 4)>(p, smem, bid, G); __syncthreads(); }
    ph_moe<1>(p, smem, bid, G);                   xcd_barrier(bar);
#ifndef CBP
#define CBP 0
#endif
    if (CBP) { ph_comb<true>(p, smem, bid, G); __syncthreads(); }
    ph_comb<false>(p, smem, bid, G);
}
#else
__global__ void __launch_bounds__(NTHR) k_p0(P p) { phase_p0(p, smem_dyn, blockIdx.x, gridDim.x); }
__global__ void __launch_bounds__(NTHR) k_norm1(P p) { ph_norm1(p, blockIdx.x, gridDim.x); phase_conv(p, smem_dyn, blockIdx.x, gridDim.x, 0, NT_WIN); }
__global__ void __launch_bounds__(NTHR) k_inproj(P p) { ph_inproj(p, smem_dyn, blockIdx.x, gridDim.x); }
__global__ void __launch_bounds__(NTHR) k_prep(P p) { ph_prep(p, smem_dyn, blockIdx.x, gridDim.x); }
__global__ void __launch_bounds__(NTHR) k_g1(P p) { ph_gla<false>(p, smem_dyn, blockIdx.x, gridDim.x); }
__global__ void __launch_bounds__(NTHR) k_g2(P p) { phase_g2(p, blockIdx.x, gridDim.x); phase_conv(p, smem_dyn, blockIdx.x, gridDim.x, NT_WIN, NT_ALL); }
__global__ void __launch_bounds__(NTHR) k_g3(P p) { ph_gla<true>(p, smem_dyn, blockIdx.x, gridDim.x); }
__global__ void __launch_bounds__(NTHR) k_att(P p) { ph_att<0>(p, smem_dyn, blockIdx.x, gridDim.x); }
__global__ void __launch_bounds__(NTHR) k_b1(P p) { ph_b1(p, smem_dyn, blockIdx.x, gridDim.x); }
__global__ void __launch_bounds__(NTHR) k_b2(P p) { ph_b2(p, smem_dyn, blockIdx.x, gridDim.x); }
__global__ void __launch_bounds__(NTHR) k_norm2(P p) { ph_norm2(p, blockIdx.x, gridDim.x); }
__global__ void __launch_bounds__(NTHR) k_f1(P p) { ph_f1(p, smem_dyn, blockIdx.x, gridDim.x); }
__global__ void __launch_bounds__(NTHR) k_route(P p) { ph_route(p, smem_dyn, blockIdx.x, gridDim.x); }
__global__ void __launch_bounds__(NTHR) k_m1(P p) { ph_moe<0>(p, smem_dyn, blockIdx.x, gridDim.x); }
__global__ void __launch_bounds__(NTHR) k_m2(P p) { ph_moe<1>(p, smem_dyn, blockIdx.x, gridDim.x); }
__global__ void __launch_bounds__(NTHR) k_comb(P p) { ph_comb<false>(p, smem_dyn, blockIdx.x, gridDim.x); }
#endif

extern "C" void kernel_launch(void* const* d_in, const int* in_sizes, int n_in, void* d_out, int out_size, void* d_ws, size_t ws_size, hipStream_t stream) {
    P p{};
    p.x = (const float*)d_in[0]; p.c = (const float*)d_in[1]; p.pos = (const int*)d_in[2]; p.w_ada = (const float*)d_in[3]; p.b_ada = (const float*)d_in[4]; p.norm1_g = (const float*)d_in[5];
    p.w_in = (const float*)d_in[6]; p.gla_w_a2 = (const float*)d_in[7]; p.gla_b_a = (const float*)d_in[8]; p.gla_onorm_g = (const float*)d_in[9]; p.qn_g = (const float*)d_in[10]; p.kn_g = (const float*)d_in[11];
    p.lq1 = (const float*)d_in[12]; p.lk1 = (const float*)d_in[13]; p.lq2 = (const float*)d_in[14]; p.lk2 = (const float*)d_in[15]; p.subln_g = (const float*)d_in[16];
    p.w_bg = (const float*)d_in[17]; p.w_bd = (const float*)d_in[18]; p.w_out = (const float*)d_in[19]; p.norm2_g = (const float*)d_in[20]; p.w_router = (const float*)d_in[21]; p.router_bias = (const float*)d_in[22];
    p.w_eg = (const float*)d_in[23]; p.w_eu = (const float*)d_in[24]; p.w_ed = (const float*)d_in[25]; p.w_sg = (const float*)d_in[26]; p.w_su = (const float*)d_in[27]; p.w_sd = (const float*)d_in[28];
    p.out = (float*)d_out; p.ws = (unsigned char*)d_ws;
    for (int i = 0; i < 8; ++i) p.invf[i] = (float)pow(500000.0, -(double)i / 8.0);
    (void)hipMemsetAsync(d_ws, 0, 64 << 10, stream);
#if MK_FUSED
    static int grid = 0;
    if (!grid) {
        int dev = 0, cus = 0, per_cu = 0;
        (void)hipGetDevice(&dev);
        (void)hipDeviceGetAttribute(&cus, hipDeviceAttributeMultiprocessorCount, dev);
        (void)hipFuncSetAttribute((const void*)k_fused, hipFuncAttributeMaxDynamicSharedMemorySize, LDS_BYTES);
        (void)hipOccupancyMaxActiveBlocksPerMultiprocessor(&per_cu, (const void*)k_fused, NTHR, LDS_BYTES);
        if (cus <= 0) cus = 256;
        grid = cus * (per_cu < 1 ? 1 : 1);
    }
    k_fused<<<grid, NTHR, LDS_BYTES, stream>>>(p);
#else
    static bool attr_done = false;
    if (!attr_done) { (void)hipFuncSetAttribute((const void*)k_g3, hipFuncAttributeMaxDynamicSharedMemorySize, 88 * 1024); attr_done = true; }
    const int G = 256;
    k_p0<<<G, NTHR, 32 * 1024, stream>>>(p);
    k_norm1<<<G, NTHR, 32 * 1024, stream>>>(p);
    k_inproj<<<G, NTHR, 0, stream>>>(p);
    k_prep<<<G, NTHR, 24 * 1024, stream>>>(p);
    k_g1<<<G, NTHR, 0, stream>>>(p);
    k_g2<<<G, NTHR, 32 * 1024, stream>>>(p);
    k_g3<<<G, NTHR, 88 * 1024, stream>>>(p);
    k_att<<<G, NTHR, 0, stream>>>(p);
    k_b1<<<G, NTHR, 0, stream>>>(p);
    k_b2<<<G, NTHR, 0, stream>>>(p);
    k_norm2<<<G, NTHR, 0, stream>>>(p);
    k_f1<<<G, NTHR, 0, stream>>>(p);
    k_route<<<G, NTHR, 0, stream>>>(p);
    k_m1<<<G, NTHR, 12288, stream>>>(p);
    k_m2<<<G, NTHR, 12288, stream>>>(p);
    k_comb<<<G, NTHR, 4096, stream>>>(p);
#endif
}
```
